# Optimizing an MI355X kernel written in HIP

```python
import math
import jax, jax.numpy as jnp
from jax import lax
import numpy as np

D_MODEL = 1024
BATCH = 8
SEQ = 4096
DEPTH = 1

ATTN_HEADS = 8
ATTN_HEAD_DIM = 64
ATTN_WIDTH = ATTN_HEADS * ATTN_HEAD_DIM
IDX_HEADS = 8
IDX_DIM = 64
TOPK_MAX = 256
Q_BLOCK = 128
REL_BUCKETS = 32
REL_MAX_DISTANCE = 128
RWKV_HEADS = 8
RWKV_HEAD_DIM = 64
RWKV_WIDTH = RWKV_HEADS * RWKV_HEAD_DIM
DECAY_LORA = 64
AAA_LORA = 64
GATE_LORA = 160
FFN_HIDDEN = ((8 * D_MODEL + 3 * 256 - 1) // (3 * 256)) * 256

RMS_EPS = 1e-6
GN_EPS = 64e-5

ATTN_SPLITS = (ATTN_WIDTH, ATTN_WIDTH, ATTN_WIDTH, IDX_HEADS * IDX_DIM, IDX_DIM, IDX_HEADS)
RWKV_SPLITS = (RWKV_WIDTH, RWKV_WIDTH, RWKV_WIDTH, DECAY_LORA, AAA_LORA, GATE_LORA)
ATTN_IN = sum(ATTN_SPLITS)
RWKV_IN = sum(RWKV_SPLITS)
GATE_IN = 2 * D_MODEL
IN_WIDTH = ATTN_IN + RWKV_IN + GATE_IN

kernel_name = 'hybrid_dsa_rwkv7_gated_block'


def _split(z, sizes):
    return jnp.split(z, [int(o) for o in np.cumsum(sizes)[:-1]], axis=-1)


def _rms_norm(x, gain):
    xf = x.astype(jnp.float32)
    y = xf * lax.rsqrt(jnp.mean(xf * xf, axis=-1, keepdims=True) + RMS_EPS)
    return (y * gain.astype(jnp.float32)).astype(x.dtype)


def _t5_bucket(dist):
    max_exact = REL_BUCKETS // 2
    d = jnp.maximum(dist, 0)
    log_ratio = jnp.log(jnp.maximum(d, 1).astype(jnp.float32) / max_exact) / math.log(REL_MAX_DISTANCE / max_exact)
    large = jnp.minimum(max_exact + (log_ratio * (REL_BUCKETS - max_exact)).astype(jnp.int32), REL_BUCKETS - 1)
    return jnp.where(d < max_exact, d, large)


def _sparse_attention(q, k, v, q_idx, k_idx, w_idx, rel_bias, topk):
    B, S, H, Dh = q.shape
    f32 = jnp.float32
    n_blocks = S // Q_BLOCK
    key_pos = jnp.arange(S, dtype=jnp.int32)
    batch_ix = jnp.arange(B)[:, None, None]
    k_idx32 = k_idx.astype(f32)
    rel_bias32 = rel_bias.astype(f32)
    scale = Dh ** -0.5

    def block(i):
        start = i * Q_BLOCK
        qb = lax.dynamic_slice_in_dim(q, start, Q_BLOCK, axis=1)
        qib = lax.dynamic_slice_in_dim(q_idx, start, Q_BLOCK, axis=1).astype(f32)
        wib = lax.dynamic_slice_in_dim(w_idx, start, Q_BLOCK, axis=1).astype(f32)
        q_pos = start + jnp.arange(Q_BLOCK, dtype=jnp.int32)
        head_scores = jax.nn.relu(jnp.einsum('bqhd,bsd->bqhs', qib, k_idx32) * IDX_DIM ** -0.5)
        scores = jnp.einsum('bqhs,bqh->bqs', head_scores, wib) * IDX_HEADS ** -0.5
        causal = key_pos[None, :] <= q_pos[:, None]
        scores = jnp.where(causal[None], scores, -jnp.inf)
        _, sel = lax.top_k(scores, topk)
        valid = sel <= q_pos[None, :, None]
        k_sel = k[batch_ix, sel]
        v_sel = v[batch_ix, sel]
        logits = jnp.einsum('bqhd,bqkhd->bhqk', qb, k_sel).astype(f32) * scale
        bias = rel_bias32[_t5_bucket(q_pos[None, :, None] - sel)]
        logits = logits + jnp.transpose(bias, (0, 3, 1, 2))
        logits = jnp.where(valid[:, None], logits, -jnp.inf)
        probs = jax.nn.softmax(logits, axis=-1).astype(v.dtype)
        return jnp.einsum('bhqk,bqkhd->bqhd', probs, v_sel)

    out = lax.map(block, jnp.arange(n_blocks, dtype=jnp.int32))
    return jnp.moveaxis(out, 0, 1).reshape(B, S, H * Dh)


def _rwkv7_time_mix(z, mu, w0, w2, a0, a2, g2, k_k, k_a, r_k, ln_w, ln_b):
    B, S, _ = z.shape
    H, N = RWKV_HEADS, RWKV_HEAD_DIM
    f32 = jnp.float32
    z = z.astype(f32)
    z_prev = jnp.pad(z, ((0, 0), (1, 0), (0, 0)))[:, :-1]
    z = z + mu * (z_prev - z)
    r, k, v, w_lo, a_lo, g_lo = _split(z, RWKV_SPLITS)
    w = -jax.nn.softplus(-(w0 + jnp.tanh(w_lo) @ w2)) - 0.5
    a = jax.nn.sigmoid(a0 + a_lo @ a2)
    g = jax.nn.sigmoid(g_lo) @ g2
    kk = (k * k_k).reshape(B, S, H, N)
    kk = kk / jnp.maximum(jnp.sqrt(jnp.sum(kk * kk, axis=-1, keepdims=True)), 1e-12)
    k = k * (1.0 + (a - 1.0) * k_a)

    def heads(t):
        return t.reshape(B, S, H, N)

    r_h, k_h, v_h, a_h = heads(r), heads(k), heads(v), heads(a)
    decay = jnp.exp(-jnp.exp(heads(w)))
    b_h = kk * a_h

    def step(state, inp):
        r_t, d_t, k_t, v_t, kk_t, b_t = inp
        s_a = jnp.einsum('bhvk,bhk->bhv', state, -kk_t)
        state = state * d_t[:, :, None, :] + s_a[..., None] * b_t[:, :, None, :] + v_t[..., None] * k_t[:, :, None, :]
        return state, jnp.einsum('bhvk,bhk->bhv', state, r_t)

    xs = tuple(jnp.moveaxis(t, 1, 0) for t in (r_h, decay, k_h, v_h, kk, b_h))
    _, y = lax.scan(step, jnp.zeros((B, H, N, N), f32), xs)
    y = jnp.moveaxis(y, 0, 1)
    mean = jnp.mean(y, axis=-1, keepdims=True)
    var = jnp.mean(jnp.square(y - mean), axis=-1, keepdims=True)
    y = ((y - mean) * lax.rsqrt(var + GN_EPS)).reshape(B, S, RWKV_WIDTH) * ln_w + ln_b
    bonus = jnp.sum(r_h * k_h * r_k, axis=-1, keepdims=True) * v_h
    y = y + bonus.reshape(B, S, RWKV_WIDTH)
    return y * g


def setup_inputs(seed: int = 0) -> dict:
    key = jax.random.key(seed)
    ks = jax.random.split(key, 24)
    L = DEPTH

    def nrm(k, shape, scale):
        return jax.random.normal(k, shape, jnp.float32) * scale

    return {
        'x': nrm(ks[0], (BATCH, SEQ, D_MODEL), 1.0),
        'mix_norm': 1.0 + nrm(ks[1], (L, D_MODEL), 0.02),
        'w_in': nrm(ks[2], (L, D_MODEL, IN_WIDTH), D_MODEL ** -0.5),
        'attn_q_norm': 1.0 + nrm(ks[3], (L, ATTN_HEAD_DIM), 0.02),
        'attn_k_norm': 1.0 + nrm(ks[4], (L, ATTN_HEAD_DIM), 0.02),
        'rel_bias': nrm(ks[5], (REL_BUCKETS, ATTN_HEADS), 0.5),
        'rwkv_mu': jax.random.uniform(ks[6], (L, RWKV_IN), jnp.float32, 0.0, 1.0),
        'rwkv_w0': nrm(ks[7], (L, RWKV_WIDTH), 0.5),
        'rwkv_w2': nrm(ks[8], (L, DECAY_LORA, RWKV_WIDTH), 0.1),
        'rwkv_a0': nrm(ks[9], (L, RWKV_WIDTH), 0.1),
        'rwkv_a2': nrm(ks[10], (L, AAA_LORA, RWKV_WIDTH), 0.1),
        'rwkv_g2': nrm(ks[11], (L, GATE_LORA, RWKV_WIDTH), GATE_LORA ** -0.5),
        'rwkv_k_k': 0.85 + nrm(ks[12], (L, RWKV_WIDTH), 0.02),
        'rwkv_k_a': 1.0 + nrm(ks[13], (L, RWKV_WIDTH), 0.02),
        'rwkv_r_k': nrm(ks[14], (L, RWKV_HEADS, RWKV_HEAD_DIM), 0.1),
        'rwkv_ln_w': 1.0 + nrm(ks[15], (L, RWKV_WIDTH), 0.02),
        'rwkv_ln_b': nrm(ks[16], (L, RWKV_WIDTH), 0.02),
        'w_branch_attn': nrm(ks[17], (L, ATTN_WIDTH, D_MODEL), ATTN_WIDTH ** -0.5),
        'w_branch_rwkv': nrm(ks[18], (L, RWKV_WIDTH, D_MODEL), RWKV_WIDTH ** -0.5),
        'w_out': nrm(ks[19], (L, D_MODEL, D_MODEL), D_MODEL ** -0.5),
        'ffn_norm': 1.0 + nrm(ks[20], (L, D_MODEL), 0.02),
        'w_gate_up': nrm(ks[21], (L, D_MODEL, 2 * FFN_HIDDEN), D_MODEL ** -0.5),
        'w_down': nrm(ks[22], (L, FFN_HIDDEN, D_MODEL), FFN_HIDDEN ** -0.5),
    }


def reference(x, mix_norm, w_in, attn_q_norm, attn_k_norm, rel_bias, rwkv_mu, rwkv_w0, rwkv_w2,
              rwkv_a0, rwkv_a2, rwkv_g2, rwkv_k_k, rwkv_k_a, rwkv_r_k, rwkv_ln_w, rwkv_ln_b,
              w_branch_attn, w_branch_rwkv, w_out, ffn_norm, w_gate_up, w_down):
    B, S, _ = x.shape
    topk = min(TOPK_MAX, S // 4)
    h = x
    for l in range(DEPTH):
        xn = _rms_norm(h, mix_norm[l])
        proj = xn @ w_in[l]
        attn_cols, rwkv_cols, gate_cols = _split(proj, (ATTN_IN, RWKV_IN, GATE_IN))
        q, k, v, q_idx, k_idx, w_idx = _split(attn_cols, ATTN_SPLITS)
        q = _rms_norm(q.reshape(B, S, ATTN_HEADS, ATTN_HEAD_DIM), attn_q_norm[l])
        k = _rms_norm(k.reshape(B, S, ATTN_HEADS, ATTN_HEAD_DIM), attn_k_norm[l])
        v = v.reshape(B, S, ATTN_HEADS, ATTN_HEAD_DIM)
        y_attn = _sparse_attention(q, k, v, q_idx.reshape(B, S, IDX_HEADS, IDX_DIM), k_idx, w_idx,
                                   rel_bias, topk)
        y_rwkv = _rwkv7_time_mix(rwkv_cols, rwkv_mu[l], rwkv_w0[l], rwkv_w2[l], rwkv_a0[l], rwkv_a2[l],
                                 rwkv_g2[l], rwkv_k_k[l], rwkv_k_a[l], rwkv_r_k[l], rwkv_ln_w[l],
                                 rwkv_ln_b[l]).astype(x.dtype)
        gate_attn, gate_rwkv = _split(gate_cols, (D_MODEL, D_MODEL))
        merged = (jax.nn.sigmoid(gate_attn) * (y_attn @ w_branch_attn[l])
                  + jax.nn.sigmoid(gate_rwkv) * (y_rwkv @ w_branch_rwkv[l]))
        h = h + merged @ w_out[l]
        hn = _rms_norm(h, ffn_norm[l])
        gate, up = _split(hn @ w_gate_up[l], (FFN_HIDDEN, FFN_HIDDEN))
        h = h + (jax.nn.silu(gate) * up) @ w_down[l]
    return h
```

```cpp
#include <hip/hip_runtime.h>
#include <cstdio>
#include <cstdint>
namespace pg8 {
#define PG8_LAS __attribute__((address_space(3)))
typedef unsigned short bf16_t;
typedef short bf16x8 __attribute__((ext_vector_type(8)));
typedef float f32x4 __attribute__((ext_vector_type(4)));
typedef unsigned u32x4 __attribute__((ext_vector_type(4)));
constexpr int BM = 256, BK = 64, HALF = 128, HTB = HALF * BK * 2  , STAGE_BYTES = 8 * HTB, NXCD = 8, WGM = 8;

__host__ __device__ __forceinline__ int lds_byte(int r, int c) { const int st = (r >> 4) * 2 + (c >> 5), rr = r & 15, cc = c & 31, ob = rr * 64 + cc * 2; return st * 1024 + (ob ^ (((ob >> 9) & 1) << 5)); }
__host__ __device__ __forceinline__ void stage_rc(int b, int& R, int& C) { const int st = b / 1024, sb = b % 1024, swz = sb ^ (((sb >> 9) & 1) << 5); R = (st >> 1) * 16 + swz / 64; C = (st & 1) * 32 + (swz % 64) / 2; }
__host__ __device__ __forceinline__ int perm32(int rho) { const int n = rho >> 4, i = rho & 15; return 8 * (i >> 2) + 4 * n + (i & 3); }

struct Unit { int pm, pn; };
struct Gemm { const bf16_t* A; const bf16_t* Bt; int M, N, K; };

struct StaticOrder {
    int nM, nN, nwg, G, c;
    __host__ __device__ void init(int M, int N, int G_, int c_) { nM = M / BM; nN = N / BM; nwg = nM * nN; G = G_; c = c_; }
    __host__ __device__ bool next(int i, Unit& u) const {
        const long L = (long)i * G + c; if (L >= nwg) return false;
        int wgid = (int)L; { const int q = nwg / NXCD, r = nwg % NXCD, xcd = wgid % NXCD, off = wgid / NXCD; wgid = (xcd < r ? xcd * (q + 1) : r * (q + 1) + (xcd - r) * q) + off; }
        const int nig = WGM * nN, gid = wgid / nig, fm = gid * WGM, gsz = (nM - fm) < WGM ? (nM - fm) : WGM;
        u.pm = fm + ((wgid % nig) % gsz); u.pn = (wgid % nig) / gsz; return true;
    }
    __device__ __forceinline__ void a_ready(const Unit&) const {}
    __device__ __forceinline__ void done(const Unit&) const {}
};
__device__ __forceinline__ unsigned cvt_pk_bf16(float lo, float hi) { unsigned r; asm volatile("v_cvt_pk_bf16_f32 %0, %1, %2" : "=v"(r) : "v"(lo), "v"(hi)); return r; }
typedef float f32x2 __attribute__((ext_vector_type(2)));
template <class Epi, class Sched, bool ALIGN_EPI = false, bool SP2 = false>
__device__ __forceinline__ void gemm_phase(PG8_LAS unsigned char* lds, const Gemm g, const Sched& S, const Epi& E) {
    const int tid = threadIdx.x, wid = __builtin_amdgcn_readfirstlane(tid >> 6), lane = tid & 63, wr = wid >> 2, wc = wid & 3, fr = lane & 15, fq = lane >> 4;
    const int K = g.K, nt = K / BK;
    unsigned voffA[2], voffB[2];
#pragma unroll
    for (int i = 0; i < 2; ++i) { int R, C; stage_rc(tid * 16 + i * 8192, R, C); const int Rb = Epi::PERM ? ((R & ~31) + perm32(R & 31)) : R;
        voffA[i] = (unsigned)(R * K + C) * 2u; voffB[i] = (unsigned)(Rb * K + C) * 2u; }
    const size_t kstep = (size_t)(BK * 2);
    const size_t hstep = (size_t)HALF * K * 2;
    const size_t tstep = 2 * hstep;
    const unsigned ldsw = (unsigned)wid * 1024u;
    const int aoff = lds_byte(wr * 64 + fr, fq * 8), boff = lds_byte(wc * 32 + fr, fq * 8);
#define PG8_SA(b, h) (((b) * 2 + (h)) * HTB)
#define PG8_SB(b, h) ((4 + (b) * 2 + (h)) * HTB)
#define PG8_STAGE(bufoff, gbase, voff) do { _Pragma("unroll") for (int _i = 0; _i < 2; ++_i) \
        __builtin_amdgcn_global_load_lds((const unsigned*)((const char*)(gbase) + (voff)[_i]), (PG8_LAS unsigned*)(lds + (bufoff) + ldsw + _i * 8192), 16, 0, 0); } while (0)
#define PG8_LDA(dst, b, h) do { _Pragma("unroll") for (int m = 0; m < 4; ++m) _Pragma("unroll") for (int k = 0; k < 2; ++k) dst[m][k] = *(const PG8_LAS bf16x8*)(lds + PG8_SA(b, h) + aoff + m * 2048 + k * 1024); } while (0)
#define PG8_LDB(dst, b, h) do { _Pragma("unroll") for (int n = 0; n < 2; ++n) _Pragma("unroll") for (int k = 0; k < 2; ++k) dst[n][k] = *(const PG8_LAS bf16x8*)(lds + PG8_SB(b, h) + boff + n * 2048 + k * 1024); } while (0)
#define PG8_MMA(ai, bj, At, Bt) do { __builtin_amdgcn_s_setprio(1); _Pragma("unroll") for (int m = 0; m < 4; ++m) _Pragma("unroll") for (int n = 0; n < 2; ++n) _Pragma("unroll") for (int k = 0; k < 2; ++k) \
        acc[ai][bj][m][n] = __builtin_amdgcn_mfma_f32_16x16x32_bf16(Bt[n][k], At[m][k], acc[ai][bj][m][n], 0, 0, 0); __builtin_amdgcn_s_setprio(0); } while (0)
#define PG8_WAIT_V(n) asm volatile("s_waitcnt vmcnt(" #n ")" ::: "memory")
#define PG8_WAIT_L(n) asm volatile("s_waitcnt lgkmcnt(" #n ")" ::: "memory")
#define PG8_BAR __builtin_amdgcn_s_barrier()
#define PG8_SCHED __builtin_amdgcn_sched_barrier(0)
    Unit cur, nxt; int ui = 0;
    if (!S.next(0, cur)) return;
    f32x4 acc[2][2][4][2];
#pragma unroll
    for (int a = 0; a < 2; ++a)
#pragma unroll
        for (int b = 0; b < 2; ++b)
#pragma unroll
            for (int m = 0; m < 4; ++m)
#pragma unroll
                for (int n = 0; n < 2; ++n) acc[a][b][m][n] = (f32x4){0.f, 0.f, 0.f, 0.f};
    bf16x8 At[4][2], B0[2][2], B1[2][2];
    const char* cA = (const char*)g.A + (size_t)cur.pm * tstep; const char* cB = (const char*)g.Bt + (size_t)cur.pn * tstep;
    S.a_ready(cur);
    if constexpr (SP2) {
        PG8_STAGE(PG8_SB(0, 0), cB, voffB); PG8_STAGE(PG8_SB(0, 1), cB + hstep, voffB); PG8_STAGE(PG8_SA(0, 0), cA, voffA); PG8_STAGE(PG8_SA(0, 1), cA + hstep, voffA);
        if (wr == 1) PG8_BAR;
        PG8_WAIT_V(2); PG8_BAR;
        PG8_STAGE(PG8_SB(1, 0), cB + kstep, voffB); PG8_STAGE(PG8_SA(1, 0), cA + kstep, voffA); PG8_STAGE(PG8_SB(1, 1), cB + hstep + kstep, voffB);
        PG8_WAIT_V(6); PG8_BAR;
    } else {
        PG8_STAGE(PG8_SB(0, 0), cB, voffB); PG8_STAGE(PG8_SA(0, 0), cA, voffA); PG8_STAGE(PG8_SB(0, 1), cB + hstep, voffB); PG8_STAGE(PG8_SA(0, 1), cA + hstep, voffA);
        if (wr == 1) PG8_BAR;
        PG8_WAIT_V(4); PG8_BAR;
        PG8_STAGE(PG8_SB(1, 0), cB + kstep, voffB); PG8_STAGE(PG8_SA(1, 0), cA + kstep, voffA); PG8_STAGE(PG8_SB(1, 1), cB + hstep + kstep, voffB);
        PG8_WAIT_V(6); PG8_BAR;
    }
    for (;;) {
        const bool has_next = S.next(ui + 1, nxt);
        const char* nA = has_next ? (const char*)g.A + (size_t)nxt.pm * tstep : cA; const char* nB = has_next ? (const char*)g.Bt + (size_t)nxt.pn * tstep : cB;
        _Pragma("unroll 1") for (int t = 0; t < nt; t += 2) {
            if constexpr (Epi::MID_T > 0) { if (t == Epi::MID_T) E.mid(acc, cur, wr, wc, fr, fq); }
            const bool last = (t == nt - 2);
            const char* a1 = cA + (size_t)(t + 1) * kstep;
            const char* a2 = last ? nA : cA + (size_t)(t + 2) * kstep; const char* b2 = last ? nB : cB + (size_t)(t + 2) * kstep;
            const char* a3 = a2 + kstep; const char* b3 = b2 + kstep;
            if (last && has_next) S.a_ready(nxt);
            if constexpr (SP2) {
            PG8_LDB(B0, 0, 0); PG8_LDB(B1, 0, 1); PG8_SCHED; PG8_LDA(At, 0, 0); PG8_STAGE(PG8_SA(1, 1), a1 + hstep, voffA);
            PG8_WAIT_V(8); PG8_WAIT_L(0); PG8_BAR; PG8_MMA(0, 0, At, B0); PG8_MMA(0, 1, At, B1); PG8_BAR; PG8_SCHED;
            PG8_LDA(At, 0, 1); PG8_STAGE(PG8_SB(0, 0), b2, voffB); PG8_STAGE(PG8_SB(0, 1), b2 + hstep, voffB); PG8_STAGE(PG8_SA(0, 0), a2, voffA);
            PG8_WAIT_V(8); PG8_WAIT_L(0); PG8_BAR; PG8_MMA(1, 0, At, B0); PG8_MMA(1, 1, At, B1); PG8_BAR; PG8_SCHED;
            PG8_LDB(B0, 1, 0); PG8_LDB(B1, 1, 1); PG8_SCHED; PG8_LDA(At, 1, 0); PG8_STAGE(PG8_SA(0, 1), a2 + hstep, voffA);
            PG8_WAIT_V(8); PG8_WAIT_L(0); PG8_BAR; PG8_MMA(0, 0, At, B0); PG8_MMA(0, 1, At, B1); PG8_BAR; PG8_SCHED;
            PG8_LDA(At, 1, 1); PG8_STAGE(PG8_SB(1, 0), b3, voffB); PG8_STAGE(PG8_SB(1, 1), b3 + hstep, voffB); PG8_STAGE(PG8_SA(1, 0), a3, voffA);
            PG8_WAIT_V(8); PG8_WAIT_L(0); PG8_BAR; PG8_MMA(1, 0, At, B0); PG8_MMA(1, 1, At, B1); PG8_BAR; PG8_SCHED;
            } else {
            PG8_LDB(B0, 0, 0); PG8_SCHED; PG8_LDA(At, 0, 0); PG8_STAGE(PG8_SA(1, 1), a1 + hstep, voffA);
            PG8_WAIT_L(8); PG8_BAR; PG8_WAIT_L(0); PG8_MMA(0, 0, At, B0); PG8_BAR; PG8_SCHED;
            PG8_LDB(B1, 0, 1); PG8_STAGE(PG8_SB(0, 0), b2, voffB);
            PG8_BAR; PG8_WAIT_L(0); PG8_MMA(0, 1, At, B1); PG8_BAR;
            PG8_LDA(At, 0, 1); PG8_STAGE(PG8_SA(0, 0), a2, voffA);
            PG8_BAR; PG8_WAIT_L(0); PG8_MMA(1, 0, At, B0); PG8_BAR; PG8_SCHED;
            PG8_STAGE(PG8_SB(0, 1), b2 + hstep, voffB);
            PG8_WAIT_V(6); PG8_BAR; PG8_MMA(1, 1, At, B1); PG8_BAR;
            PG8_LDB(B0, 1, 0); PG8_SCHED; PG8_LDA(At, 1, 0); PG8_STAGE(PG8_SA(0, 1), a2 + hstep, voffA);
            PG8_WAIT_L(8); PG8_BAR; PG8_WAIT_L(0); PG8_MMA(0, 0, At, B0); PG8_BAR; PG8_SCHED;
            PG8_LDB(B1, 1, 1); PG8_STAGE(PG8_SB(1, 0), b3, voffB);
            PG8_BAR; PG8_WAIT_L(0); PG8_MMA(0, 1, At, B1); PG8_BAR;
            PG8_LDA(At, 1, 1); PG8_STAGE(PG8_SA(1, 0), a3, voffA);
            PG8_BAR; PG8_WAIT_L(0); PG8_MMA(1, 0, At, B0); PG8_BAR; PG8_SCHED;
            PG8_STAGE(PG8_SB(1, 1), b3 + hstep, voffB);
            PG8_WAIT_V(6); PG8_BAR; PG8_MMA(1, 1, At, B1); PG8_BAR;
            }
        }
        if constexpr (ALIGN_EPI) { if (wr == 0) PG8_BAR; }
        if constexpr (!Epi::AFTER_DRAIN) { E(acc, cur, wr, wc, fr, fq); S.done(cur); }
        if (!has_next) break;
#pragma unroll
        for (int a = 0; a < 2; ++a)
#pragma unroll
            for (int b = 0; b < 2; ++b)
#pragma unroll
                for (int m = 0; m < 4; ++m)
#pragma unroll
                    for (int n = 0; n < 2; ++n) acc[a][b][m][n] = (f32x4){0.f, 0.f, 0.f, 0.f};
        cur = nxt; cA = nA; cB = nB; ++ui;
        if constexpr (ALIGN_EPI) { if (wr == 1) PG8_BAR; }
    }
    PG8_WAIT_V(0);
    if constexpr (!ALIGN_EPI) { if (wr == 0) PG8_BAR; }
    PG8_BAR;
    if constexpr (Epi::AFTER_DRAIN) { E.fused(acc, cur, wr, wc, fr, fq, lds, wid, lane); S.done(cur); }
#undef PG8_SA
#undef PG8_SB
#undef PG8_STAGE
#undef PG8_LDA
#undef PG8_LDB
#undef PG8_MMA
#undef PG8_WAIT_V
#undef PG8_WAIT_L
#undef PG8_BAR
#undef PG8_SCHED
}
}
#define LAS __attribute__((address_space(3)))
typedef unsigned short bf16;
typedef short bf16x8 __attribute__((ext_vector_type(8)));
typedef float f32x4 __attribute__((ext_vector_type(4)));
typedef float f32x16 __attribute__((ext_vector_type(16)));
typedef unsigned u32x4 __attribute__((ext_vector_type(4)));
typedef unsigned u32x2 __attribute__((ext_vector_type(2)));
typedef short s16x4 __attribute__((ext_vector_type(4)));

constexpr int NB = 8, SEQ = 4096, T = NB * SEQ, DM = 1024;
constexpr int IN_W = 5992, NPROJ = 6144, RWW = 1824, FFH = 2816, LK = 384, LN_ = 1536;
constexpr float C2 = 0.125f * 1.4426950408889634f;
constexpr float LOG2E = 1.4426950408889634f;
constexpr size_t MiB = 1u << 20;
constexpr size_t WS_CTL = 0;
constexpr size_t WS_WIN = 1 * MiB, WS_WGU = 13 * MiB, WS_WD = 24 * MiB, WS_WO = 30 * MiB, WS_WBA = 32 * MiB, WS_WBR = 33 * MiB, WS_WL = 34 * MiB;
constexpr size_t WS_Q = 36 * MiB, WS_K = 68 * MiB, WS_V = 100 * MiB;
constexpr size_t WS_QI = 132 * MiB;
constexpr size_t WS_AA = 132 * MiB;
constexpr size_t WS_YA2 = 379 * MiB;
constexpr size_t WS_KI = 164 * MiB, WS_WI = 168 * MiB;
constexpr size_t WS_XN = 169 * MiB;
constexpr size_t WS_Z = 233 * MiB;
constexpr size_t WS_GG = 347 * MiB, WS_BV = 132 * MiB  , WS_KK = 265 * MiB, WS_BB = 297 * MiB;
constexpr size_t WS_MRG = 36 * MiB;
constexpr size_t WS_SSQ = 329 * MiB;
constexpr size_t WS_ACT = 331 * MiB;
constexpr size_t WS_SCR = 347 * MiB;
constexpr size_t WS_RKV = 347 * MiB;
constexpr size_t WS_A12 = 443 * MiB;
constexpr size_t WS_Y = 443 * MiB;
constexpr size_t WS_MASK = 475 * MiB;
constexpr size_t WS_RW = 36 * MiB, WS_Y0 = 68 * MiB, WS_P = 100 * MiB;
constexpr size_t WS_QT = 475 * MiB;
constexpr size_t WS_SC = 169 * MiB;
constexpr size_t WS_END = 507 * MiB;

constexpr int LDS_BYTES = 155648;

__device__ __forceinline__ unsigned f2bf(float f) { const __bf16 b = (__bf16)f; return (unsigned)__builtin_bit_cast(unsigned short, b); }
typedef float pk_f32x2_t __attribute__((ext_vector_type(2))); typedef __bf16 pk_bf16x2_t __attribute__((ext_vector_type(2)));
__device__ __forceinline__ unsigned pk2(float lo, float hi) { pk_f32x2_t v = {lo, hi}; pk_bf16x2_t b = __builtin_convertvector(v, pk_bf16x2_t); return __builtin_bit_cast(unsigned, b); }
__device__ __forceinline__ float bflo(unsigned w) { return __builtin_bit_cast(float, w << 16); }
__device__ __forceinline__ float bfhi(unsigned w) { return __builtin_bit_cast(float, w & 0xffff0000u); }
__device__ __forceinline__ float sigmoidf_(float x) { return __builtin_amdgcn_rcpf(1.0f + __expf(-x)); }
__device__ __forceinline__ void unpack8(const u32x4 w, float (&f)[8]) { f[0] = bflo(w.x); f[1] = bfhi(w.x); f[2] = bflo(w.y); f[3] = bfhi(w.y); f[4] = bflo(w.z); f[5] = bfhi(w.z); f[6] = bflo(w.w); f[7] = bfhi(w.w); }
__device__ __forceinline__ u32x4 pack8(const float (&f)[8]) { u32x4 w; w.x = pk2(f[0], f[1]); w.y = pk2(f[2], f[3]); w.z = pk2(f[4], f[5]); w.w = pk2(f[6], f[7]); return w; }

struct Args { const float* in[23]; float* out; unsigned char* ws; int ph_lo, ph_hi; };

struct Frame {
    LAS unsigned char* lds; int tid, lane, wave, vcu, G;
    const float* in[23]; float* out; unsigned char* ws;
};
#define EPI_ARGS const pg8::f32x4 (&acc)[2][2][4][2], const pg8::Unit& u, int wr, int wc, int fr, int fq
__device__ __forceinline__ void acc8(const pg8::f32x4 (&acc)[2][2][4][2], int ai, int bj, int m, float (&v)[8]) {
    const pg8::f32x4 a = acc[ai][bj][m][0], b = acc[ai][bj][m][1];
    v[0] = a[0]; v[1] = a[1]; v[2] = a[2]; v[3] = a[3]; v[4] = b[0]; v[5] = b[1]; v[6] = b[2]; v[7] = b[3];
}
__device__ __forceinline__ void ld8f(const float* p, float (&v)[8]) { const f32x4 a = *(const f32x4*)p, b = *(const f32x4*)(p + 4); v[0] = a[0]; v[1] = a[1]; v[2] = a[2]; v[3] = a[3]; v[4] = b[0]; v[5] = b[1]; v[6] = b[2]; v[7] = b[3]; }
__device__ __forceinline__ void st8f(float* p, const float (&v)[8]) { *(f32x4*)p = (f32x4){v[0], v[1], v[2], v[3]}; *(f32x4*)(p + 4) = (f32x4){v[4], v[5], v[6], v[7]}; }

struct EpiInProj {
    static constexpr bool PERM = true, AFTER_DRAIN = false; static constexpr int MID_T = 0;
    bf16 *Q, *K, *V, *QI, *KI, *Z, *G; float* WI; const float *qg, *kg;
    __device__ __forceinline__ void operator()(EPI_ARGS) const {
        const int pn = u.pn, row0 = u.pm * 256 + wr * 64 + fr;
        if (pn < 4) {
            const bool isq = pn < 2; const int head = 4 * (pn & 1) + wc;
            const float* gp = isq ? qg : kg; bf16* dst = isq ? Q : K; const float osc = isq ? C2 : 1.0f;
            float g0[8], g1[8]; ld8f(gp + 8 * fq, g0); ld8f(gp + 32 + 8 * fq, g1);
#pragma unroll
            for (int ai = 0; ai < 2; ++ai)
#pragma unroll
                for (int m = 0; m < 4; ++m) {
                    float a0[8], a1[8]; acc8(acc, ai, 0, m, a0); acc8(acc, ai, 1, m, a1);
                    float ss = 0.f;
#pragma unroll
                    for (int i = 0; i < 8; ++i) ss += a0[i] * a0[i] + a1[i] * a1[i];
                    ss += __shfl_xor(ss, 16); ss += __shfl_xor(ss, 32);
                    const float rs = rsqrtf(ss * (1.0f / 64.0f) + 1e-6f) * osc;
#pragma unroll
                    for (int i = 0; i < 8; ++i) { a0[i] *= rs * g0[i]; a1[i] *= rs * g1[i]; }
                    bf16* rp = dst + (size_t)(row0 + ai * 128 + m * 16) * 512 + head * 64 + 8 * fq;
                    *(u32x4*)rp = pack8(a0); *(u32x4*)(rp + 32) = pack8(a1);
                }
        } else if (pn < 8) {
            bf16* dst = pn < 6 ? V : QI; const int c0 = (pn & 1) * 256 + wc * 32 + 8 * fq;
#pragma unroll
            for (int ai = 0; ai < 2; ++ai)
#pragma unroll
                for (int m = 0; m < 4; ++m)
#pragma unroll
                    for (int bj = 0; bj < 2; ++bj) { float a[8]; acc8(acc, ai, bj, m, a); *(u32x4*)(dst + (size_t)(row0 + ai * 128 + m * 16) * 512 + c0 + bj * 128) = pack8(a); }
        } else if (pn < 16) {
#pragma unroll
            for (int bj = 0; bj < 2; ++bj) {
                const int cr = (pn - 8) * 256 + bj * 128 + wc * 32 + 8 * fq;
#pragma unroll
                for (int ai = 0; ai < 2; ++ai)
#pragma unroll
                    for (int m = 0; m < 4; ++m) {
                        float a[8]; acc8(acc, ai, bj, m, a); const size_t row = (size_t)(row0 + ai * 128 + m * 16);
                        if (cr < RWW) *(u32x4*)(Z + row * RWW + cr) = pack8(a);
                        else if (cr < RWW + 64) *(u32x4*)(KI + row * 64 + (cr - RWW)) = pack8(a);
                        else if (cr == RWW + 64) st8f(WI + row * 8, a);
                    }
            }
        } else {
            const int c0 = (pn - 16) * 128 + wc * 32 + 8 * fq;
#pragma unroll
            for (int ai = 0; ai < 2; ++ai)
#pragma unroll
                for (int m = 0; m < 4; ++m) { float ga[8], gr[8]; acc8(acc, ai, 0, m, ga); acc8(acc, ai, 1, m, gr);
#pragma unroll
                    for (int i = 0; i < 8; ++i) { const float sr_ = sigmoidf_(gr[i]); ga[i] = sigmoidf_(ga[i]) * __builtin_amdgcn_rcpf(sr_); gr[i] = sr_; }
                    bf16* gp = G + (size_t)(row0 + ai * 128 + m * 16) * 2048 + c0;
                    *(u32x4*)gp = pack8(ga); *(u32x4*)(gp + 1024) = pack8(gr); }
        }
    }
};
template <int MODE> struct EpiLora {
    static constexpr bool PERM = true, AFTER_DRAIN = false; static constexpr int MID_T = 0;
    float* DEC; bf16* O; const float* bias;
    __device__ __forceinline__ void operator()(EPI_ARGS) const {
        const int row0 = u.pm * 256 + wr * 64 + fr, c0 = u.pn * 256 + wc * 32 + 8 * fq;
#pragma unroll
        for (int bj = 0; bj < 2; ++bj) { const int c = c0 + bj * 128; float bv[8];
            if (MODE < 2) ld8f(bias + c, bv);
#pragma unroll
            for (int ai = 0; ai < 2; ++ai)
#pragma unroll
                for (int m = 0; m < 4; ++m) { float a[8]; acc8(acc, ai, bj, m, a); const size_t row = (size_t)(row0 + ai * 128 + m * 16);
                    if (MODE == 0) {
#pragma unroll
                        for (int i = 0; i < 8; ++i) a[i] = -0.6065306597126334f * sigmoidf_(a[i] + bv[i]);
                        st8f(DEC + row * 512 + c, a);
                    } else if (MODE == 1) {
#pragma unroll
                        for (int i = 0; i < 8; ++i) a[i] = sigmoidf_(a[i] + bv[i]);
                        *(u32x4*)(O + row * 512 + c) = pack8(a);
                    } else *(u32x4*)(O + row * 512 + c) = pack8(a);
                } }
    }
};
struct EpiLoraAll {
    static constexpr bool PERM = true, AFTER_DRAIN = false; static constexpr int MID_T = 0;
    float* DEC; bf16* AAo; bf16* GGo; const float* bias0; const float* bias1;
    __device__ __forceinline__ void operator()(EPI_ARGS) const {
        pg8::Unit v = u; v.pn = u.pn & 1; const int mode = u.pn >> 1;
        if (mode == 0) { EpiLora<0> E{DEC, nullptr, bias0}; E(acc, v, wr, wc, fr, fq); }
        else if (mode == 1) { EpiLora<1> E{nullptr, AAo, bias1}; E(acc, v, wr, wc, fr, fq); }
        else { EpiLora<2> E{nullptr, GGo, nullptr}; E(acc, v, wr, wc, fr, fq); }
    }
};
struct EpiBranchFused {
    static constexpr bool PERM = true, AFTER_DRAIN = false; static constexpr int MID_T = 8;
    const bf16* G; bf16* MRG;
    __device__ __forceinline__ void mid(pg8::f32x4 (&acc)[2][2][4][2], const pg8::Unit& u, int wr, int wc, int fr, int fq) const {
        const bf16* gb = G + (size_t)(u.pm * 256 + wr * 64 + fr) * 2048 + u.pn * 256 + wc * 32 + 8 * fq;
        asm volatile("" : "+v"(gb));
#pragma unroll
        for (int ai = 0; ai < 2; ++ai)
#pragma unroll
            for (int m = 0; m < 4; ++m) { const bf16* gp = gb + (size_t)(ai * 128 + m * 16) * 2048;
#pragma unroll
                for (int bj = 0; bj < 2; ++bj) { float g[8]; unpack8(*(const u32x4*)(gp + bj * 128), g);
                    acc[ai][bj][m][0] = acc[ai][bj][m][0] * (pg8::f32x4){g[0], g[1], g[2], g[3]}; acc[ai][bj][m][1] = acc[ai][bj][m][1] * (pg8::f32x4){g[4], g[5], g[6], g[7]}; }
                asm volatile("" ::: "memory"); }
    }
    __device__ __forceinline__ void operator()(EPI_ARGS) const {
        const int row0 = u.pm * 256 + wr * 64 + fr, c0 = u.pn * 256 + wc * 32 + 8 * fq;
#pragma unroll
        for (int ai = 0; ai < 2; ++ai)
#pragma unroll
            for (int m = 0; m < 4; ++m)
#pragma unroll
                for (int bj = 0; bj < 2; ++bj) {
                    float a[8], g[8]; acc8(acc, ai, bj, m, a); const size_t row = (size_t)(row0 + ai * 128 + m * 16); const int c = c0 + bj * 128;
                    unpack8(*(const u32x4*)(G + row * 2048 + 1024 + c), g);
#pragma unroll
                    for (int i = 0; i < 8; ++i) a[i] = g[i] * a[i];
                    *(u32x4*)(MRG + row * 1024 + c) = pack8(a);
                }
    }
};
struct EpiOut {
    static constexpr bool PERM = true, AFTER_DRAIN = false; static constexpr int MID_T = 0;
    const float* x; float* out; bf16* H1B; float* SSQ;
    __device__ __forceinline__ void operator()(EPI_ARGS) const {
        const int row0 = u.pm * 256 + wr * 64 + fr, c0 = u.pn * 256 + wc * 32 + 8 * fq;
#pragma unroll
        for (int ai = 0; ai < 2; ++ai)
#pragma unroll
            for (int m = 0; m < 4; ++m) {
                const size_t row = (size_t)(row0 + ai * 128 + m * 16); float ss = 0.f;
#pragma unroll
                for (int bj = 0; bj < 2; ++bj) {
                    float a[8], xv[8]; acc8(acc, ai, bj, m, a); const int c = c0 + bj * 128; ld8f(x + row * 1024 + c, xv);
#pragma unroll
                    for (int i = 0; i < 8; ++i) { a[i] += xv[i]; ss += a[i] * a[i]; }
                    *(u32x4*)(H1B + row * 1024 + c) = pack8(a);
                }
                ss += __shfl_xor(ss, 16); ss += __shfl_xor(ss, 32);
                if (fq == 0) SSQ[row * 16 + u.pn * 4 + wc] = ss;
            }
    }
};
struct EpiGateUp {
    static constexpr bool PERM = true, AFTER_DRAIN = false; static constexpr int MID_T = 0;
    const float* SSQ; bf16* ACT;
    __device__ __forceinline__ void operator()(EPI_ARGS) const {
        const int row0 = u.pm * 256 + wr * 64 + fr, c0 = u.pn * 128 + wc * 32 + 8 * fq;
#pragma unroll
        for (int ai = 0; ai < 2; ++ai)
#pragma unroll
            for (int m = 0; m < 4; ++m) {
                const size_t row = (size_t)(row0 + ai * 128 + m * 16);
                const f32x4 s0 = *(const f32x4*)(SSQ + row * 16), s1 = *(const f32x4*)(SSQ + row * 16 + 4), s2 = *(const f32x4*)(SSQ + row * 16 + 8), s3 = *(const f32x4*)(SSQ + row * 16 + 12);
                const float tot = ((s0[0] + s0[1]) + (s0[2] + s0[3])) + ((s1[0] + s1[1]) + (s1[2] + s1[3])) + ((s2[0] + s2[1]) + (s2[2] + s2[3])) + ((s3[0] + s3[1]) + (s3[2] + s3[3]));
                const float rs = rsqrtf(tot * (1.0f / 1024.0f) + 1e-6f);
                float gt[8], up[8]; acc8(acc, ai, 0, m, gt); acc8(acc, ai, 1, m, up);
#pragma unroll
                for (int i = 0; i < 8; ++i) { const float gv = gt[i] * rs; gt[i] = gv * sigmoidf_(gv) * (up[i] * rs); }
                *(u32x4*)(ACT + row * FFH + c0) = pack8(gt);
            }
    }
};
struct EpiDown {
    static constexpr bool PERM = true, AFTER_DRAIN = false; static constexpr int MID_T = 0;
    float* out; const bf16* H1B;
    __device__ __forceinline__ void operator()(EPI_ARGS) const {
        const int row0 = u.pm * 256 + wr * 64 + fr, c0 = u.pn * 256 + wc * 32 + 8 * fq;
#pragma unroll
        for (int ai = 0; ai < 2; ++ai)
#pragma unroll
            for (int m = 0; m < 4; ++m)
#pragma unroll
                for (int bj = 0; bj < 2; ++bj) {
                    float a[8], h[8]; acc8(acc, ai, bj, m, a); const size_t off = (size_t)(row0 + ai * 128 + m * 16) * 1024 + c0 + bj * 128; unpack8(*(const u32x4*)(H1B + off), h);
#pragma unroll
                    for (int i = 0; i < 8; ++i) a[i] += h[i];
                    st8f(out + off, a);
                }
    }
};
struct WRow { const float* W; int ld, sc, koff, kcnt; };
__device__ __forceinline__ WRow wrow(const Frame& F, int mat, int n) {
    WRow r; r.koff = 0;
    switch (mat) {
    case 0: { r.W = F.in[2]; r.ld = IN_W; r.kcnt = 1024; const int pn = n >> 8, c = n & 255;
        if (pn < 4) { const int head = 4 * (pn & 1) + ((c >> 5) & 3), dim = ((c >> 7) << 5) + (c & 31); r.sc = (pn >> 1) * 512 + head * 64 + dim; }
        else if (pn < 8) r.sc = n;
        else if (pn < 16) { const int cr = n - 2048; r.sc = cr < RWW ? 2120 + cr : (cr < RWW + 64 ? 2048 + (cr - RWW) : (cr < RWW + 72 ? 2112 + (cr - RWW - 64) : -1)); }
        else { const int c = n & 255; r.sc = 3944 + (c < 128 ? 0 : 1024) + 128 * (pn - 16) + (c & 127); }
        break; }
    case 1: r.W = F.in[17]; r.ld = 1024; r.kcnt = 512; r.sc = n; break;
    case 3: r.W = F.in[19]; r.ld = 1024; r.kcnt = 1024; r.sc = n; break;
    case 4: { r.W = F.in[21]; r.ld = 2 * FFH; r.kcnt = 1024; const int pn = n >> 8, c = n & 255; r.sc = c < 128 ? 128 * pn + c : FFH + 128 * pn + (c - 128); break; }
    case 5: r.W = F.in[22]; r.ld = 1024; r.kcnt = FFH; r.sc = n; break;
    default: { r.ld = 512; if (n < 512) { r.W = F.in[8]; r.sc = n; r.koff = 0; r.kcnt = 64; } else if (n < 1024) { r.W = F.in[10]; r.sc = n - 512; r.koff = 64; r.kcnt = 64; } else { r.W = F.in[11]; r.sc = n - 1024; r.koff = 128; r.kcnt = 160; } break; }
    }
    return r;
}
struct P0Dec { int mat, Kout, nblk, r; bf16* WT; const float* scale; };
__device__ __forceinline__ P0Dec p0_dec(const Frame& F, int it) {
    constexpr int I0 = 16 * (NPROJ / 32), I1 = 16 * 32, I3 = 16 * 32, I4 = 16 * (2 * FFH / 32), I5 = (FFH / 64) * 32;
    unsigned char* ws = F.ws; P0Dec d; d.scale = nullptr; int r = it;
    if (r < I0) { d.mat = 0; d.Kout = 1024; d.nblk = NPROJ / 32; d.WT = (bf16*)(ws + WS_WIN); d.r = r; return d; } r -= I0;
    if (r < I1) { d.mat = 1; d.Kout = 1024; d.nblk = 32; d.WT = (bf16*)(ws + WS_WBA); d.r = r; return d; } r -= I1;
    if (r < I3) { d.mat = 3; d.Kout = 1024; d.nblk = 32; d.WT = (bf16*)(ws + WS_WO); d.r = r; return d; } r -= I3;
    if (r < I4) { d.mat = 4; d.Kout = 1024; d.nblk = 2 * FFH / 32; d.WT = (bf16*)(ws + WS_WGU); d.scale = F.in[20]; d.r = r; return d; } r -= I4;
    if (r < I5) { d.mat = 5; d.Kout = FFH; d.nblk = 32; d.WT = (bf16*)(ws + WS_WD); d.r = r; return d; } r -= I5;
    d.mat = 6; d.Kout = LK; d.nblk = LN_ / 32; d.WT = (bf16*)(ws + WS_WL); d.r = r; return d;
}
__device__ __forceinline__ void p0_load(const Frame& F, const P0Dec& d, float (&v)[32], f32x4 (&sv)[2]) {
    const int lane = F.lane, kb = d.r / d.nblk, nb = d.r % d.nblk, k0 = 64 * kb, n0 = 32 * nb;
    WRow r = wrow(F, d.mat, n0 + (lane & 31));
    if (d.mat == 1 && k0 >= 512) { r.W = F.in[18]; r.koff = 512; }
#pragma unroll
    for (int i = 0; i < 32; ++i) { const int kk = 2 * i + (lane >> 5), ks = k0 + kk - r.koff; v[i] = 0.f;
        if (r.sc >= 0 && ks >= 0 && ks < r.kcnt) v[i] = r.W[(size_t)ks * r.ld + r.sc]; }
    sv[0] = (f32x4){1.f, 1.f, 1.f, 1.f}; sv[1] = sv[0];
    if (d.scale) { const f32x4* sp = (const f32x4*)(d.scale + k0 + 8 * (lane & 7)); sv[0] = sp[0]; sv[1] = sp[1]; }
}
__device__ __forceinline__ void p0_store(const Frame& F, const P0Dec& d, const float (&v)[32], const f32x4 (&sv)[2], LAS float* scr) {
    const int lane = F.lane, kb = d.r / d.nblk, nb = d.r % d.nblk, k0 = 64 * kb, n0 = 32 * nb;
#pragma unroll
    for (int i = 0; i < 32; ++i) scr[(2 * i + (lane >> 5)) * 33 + (lane & 31)] = v[i];
    asm volatile("s_waitcnt lgkmcnt(0)" ::: "memory");
    const int c = lane & 7;
#pragma unroll
    for (int j = 0; j < 4; ++j) { const int n = (lane >> 3) + 8 * j; const LAS float* s = scr + (8 * c) * 33 + n;
        u32x4 o; o.x = pk2(s[0 * 33] * sv[0][0], s[1 * 33] * sv[0][1]); o.y = pk2(s[2 * 33] * sv[0][2], s[3 * 33] * sv[0][3]);
        o.z = pk2(s[4 * 33] * sv[1][0], s[5 * 33] * sv[1][1]); o.w = pk2(s[6 * 33] * sv[1][2], s[7 * 33] * sv[1][3]);
        *(u32x4*)(d.WT + (size_t)(n0 + n) * d.Kout + k0 + 8 * c) = o; }
    asm volatile("s_waitcnt lgkmcnt(0)" ::: "memory");
}
__device__ __forceinline__ float wave_sum(float v) {
#pragma unroll
    for (int o = 1; o < 64; o <<= 1) v += __shfl_xor(v, o);
    return v;
}
__device__ __forceinline__ void phase_p0(const Frame& F) {
    LAS float* scr = (LAS float*)(F.lds + F.wave * 16384);
    const int gw = F.vcu * 8 + F.wave, NGW = F.G * 8;
    constexpr int I0 = 16 * (NPROJ / 32), I1 = 16 * 32, I2 = 0, I3 = 16 * 32, I4 = 16 * (2 * FFH / 32), I5 = (FFH / 64) * 32, I6 = (LK / 64) * (LN_ / 32);
    constexpr int NITEMS = I0 + I1 + I2 + I3 + I4 + I5 + I6;
    unsigned char* ws = F.ws;
    {
        float va[32], vb[32]; f32x4 sa[2], sb[2]; P0Dec da, db;
        if (gw < NITEMS) { da = p0_dec(F, gw); p0_load(F, da, va, sa); }
#pragma unroll 1
        for (int it = gw; it < NITEMS; it += NGW) {
            const bool hb = it + NGW < NITEMS;
            if (hb) { db = p0_dec(F, it + NGW); p0_load(F, db, vb, sb); }
            p0_store(F, da, va, sa, scr);
            if (hb) { da = db; sa[0] = sb[0]; sa[1] = sb[1];
#pragma unroll
                for (int i = 0; i < 32; ++i) va[i] = vb[i]; }
        }
    }
    const float* gain = F.in[1]; bf16* XN = (bf16*)(ws + WS_XN);
    f32x4 gv[4];
#pragma unroll
    for (int j = 0; j < 4; ++j) gv[j] = *((const f32x4*)gain + F.lane + 64 * j);
    f32x4 v[4][4], vn[4][4];
#define P0_XLOAD(dst, mm) _Pragma("unroll") for (int q = 0; q < 4; ++q) { const f32x4* xr = (const f32x4*)(F.in[0] + (size_t)((mm) + q) * DM) + F.lane; \
            _Pragma("unroll") for (int j = 0; j < 4; ++j) dst[q][j] = xr[64 * j]; }
    if (4 * gw < T) P0_XLOAD(v, 4 * gw);
#pragma unroll 1
    for (int m0 = 4 * gw; m0 < T; m0 += 4 * NGW) {
        const bool hn = m0 + 4 * NGW < T;
        if (hn) P0_XLOAD(vn, m0 + 4 * NGW);
        float s[4];
#pragma unroll
        for (int q = 0; q < 4; ++q) { s[q] = 0.f;
#pragma unroll
            for (int j = 0; j < 4; ++j) s[q] += (v[q][j][0] * v[q][j][0] + v[q][j][1] * v[q][j][1]) + (v[q][j][2] * v[q][j][2] + v[q][j][3] * v[q][j][3]); }
#pragma unroll
        for (int o = 1; o < 64; o <<= 1) {
#pragma unroll
            for (int q = 0; q < 4; ++q) s[q] += __shfl_xor(s[q], o); }
#pragma unroll
        for (int q = 0; q < 4; ++q) { const float rs = rsqrtf(s[q] * (1.0f / DM) + 1e-6f); u32x2* o = (u32x2*)(XN + (size_t)(m0 + q) * DM) + F.lane;
#pragma unroll
            for (int j = 0; j < 4; ++j) { u32x2 w; w.x = pk2(v[q][j][0] * rs * gv[j][0], v[q][j][1] * rs * gv[j][1]); w.y = pk2(v[q][j][2] * rs * gv[j][2], v[q][j][3] * rs * gv[j][3]); o[64 * j] = w; } }
        if (hn) {
#pragma unroll
            for (int q = 0; q < 4; ++q) {
#pragma unroll
                for (int j = 0; j < 4; ++j) v[q][j] = vn[q][j]; } }
    }
#undef P0_XLOAD
}
__device__ __forceinline__ void phase_pr1(const Frame& F) {
    const bf16* Z = (const bf16*)(F.ws + WS_Z); bf16* A12 = (bf16*)(F.ws + WS_A12); const float* mu = F.in[6];
    if (F.tid >= 480) return;
    const int rsub = F.tid / 48, c = 192 + F.tid % 48;
    if (c >= 228) {
        for (int m0 = 4 * (10 * F.vcu + rsub); m0 < T; m0 += 40 * F.G) {
#pragma unroll
            for (int q = 0; q < 4; ++q) *(u32x4*)(A12 + (size_t)(m0 + q) * LK + 288 + 8 * (c - 228)) = (u32x4){0u, 0u, 0u, 0u}; }
        return;
    }
    float muv[8]; ld8f(mu + 8 * c, muv);
    const int col = 8 * c;
    for (int m0 = 4 * (10 * F.vcu + rsub); m0 < T; m0 += 40 * F.G) {
        u32x4 raw[5]; raw[0] = (u32x4){0u, 0u, 0u, 0u}; if ((m0 & (SEQ - 1)) != 0) raw[0] = *(const u32x4*)(Z + (size_t)(m0 - 1) * RWW + col);
#pragma unroll
        for (int q = 0; q < 4; ++q) raw[q + 1] = *(const u32x4*)(Z + (size_t)(m0 + q) * RWW + col);
        float zp[8]; unpack8(raw[0], zp);
#pragma unroll
        for (int q = 0; q < 4; ++q) {
            const int m = m0 + q; float zc[8], z[8]; unpack8(raw[q + 1], zc);
#pragma unroll
            for (int i = 0; i < 8; ++i) { z[i] = zc[i] + muv[i] * (zp[i] - zc[i]); zp[i] = zc[i]; }
            if (col < 1600) {
#pragma unroll
                for (int i = 0; i < 8; ++i) z[i] = 1.0f - 2.0f * __builtin_amdgcn_rcpf(1.0f + __expf(2.0f * z[i]));
                *(u32x4*)(A12 + (size_t)m * LK + (col - 1536)) = pack8(z);
            } else if (col < 1664) *(u32x4*)(A12 + (size_t)m * LK + 64 + (col - 1600)) = pack8(z);
            else {
#pragma unroll
                for (int i = 0; i < 8; ++i) z[i] = sigmoidf_(z[i]);
                *(u32x4*)(A12 + (size_t)m * LK + 128 + (col - 1664)) = pack8(z);
            }
        }
    }
}
__device__ __forceinline__ float sum8(float v) { v += __shfl_xor(v, 1); v += __shfl_xor(v, 2); v += __shfl_xor(v, 4); return v; }
__device__ __forceinline__ void phase_pr2(const Frame& F) {
    bf16* RKV = (bf16*)(F.ws + WS_RKV); const bf16* AA = (const bf16*)(F.ws + WS_AA); bf16* KK = (bf16*)(F.ws + WS_KK); bf16* BB = (bf16*)(F.ws + WS_BB);
    const int gw = F.vcu * 8 + F.wave, NGW = F.G * 8, l = F.lane;
    float kkw[8], kaw[8]; ld8f(F.in[12] + 8 * l, kkw); ld8f(F.in[13] + 8 * l, kaw);
    for (int m = gw; m < T; m += NGW) {
        float k[8], a[8], kk[8], b[8]; unpack8(*(const u32x4*)(RKV + (size_t)m * 1536 + 512 + 8 * l), k); unpack8(*(const u32x4*)(AA + (size_t)m * 512 + 8 * l), a);
        float ss = 0.f;
#pragma unroll
        for (int i = 0; i < 8; ++i) { kk[i] = k[i] * kkw[i]; ss += kk[i] * kk[i]; }
        ss = sum8(ss);
        const float inv = 1.0f / fmaxf(sqrtf(ss), 1e-12f);
#pragma unroll
        for (int i = 0; i < 8; ++i) { kk[i] *= inv; b[i] = kk[i] * a[i]; k[i] = k[i] * (1.0f + (a[i] - 1.0f) * kaw[i]); }
        *(u32x4*)(KK + (size_t)m * 512 + 8 * l) = pack8(kk); *(u32x4*)(BB + (size_t)m * 512 + 8 * l) = pack8(b); *(u32x4*)(RKV + (size_t)m * 1536 + 512 + 8 * l) = pack8(k);
    }
}
__device__ __forceinline__ void phase_post(const Frame& F) {
    const bf16* Y = (const bf16*)(F.ws + WS_Y); const bf16* GG = (const bf16*)(F.ws + WS_GG); const bf16* BV = (const bf16*)(F.ws + WS_BV); bf16* YA2 = (bf16*)(F.ws + WS_YA2);
    const int gw = F.vcu * 8 + F.wave, NGW = F.G * 8, l = F.lane;
    float lw[8], lb[8]; ld8f(F.in[15] + 8 * l, lw); ld8f(F.in[16] + 8 * l, lb);
    for (int m0 = 2 * gw; m0 < T; m0 += 2 * NGW) {
        u32x4 ry[2], rb[2], rg[2];
#pragma unroll
        for (int q = 0; q < 2; ++q) { const size_t o = (size_t)(m0 + q) * 512 + 8 * l; ry[q] = *(const u32x4*)(Y + o); rb[q] = *(const u32x4*)(BV + o); rg[q] = *(const u32x4*)(GG + o); }
#pragma unroll
        for (int q = 0; q < 2; ++q) {
            float y[8], bv[8], g[8]; unpack8(ry[q], y); unpack8(rb[q], bv); unpack8(rg[q], g);
            float s = 0.f;
#pragma unroll
            for (int i = 0; i < 8; ++i) s += y[i];
            s = sum8(s);
            const float mean = s * (1.0f / 64.0f); float qq = 0.f;
#pragma unroll
            for (int i = 0; i < 8; ++i) { y[i] -= mean; qq += y[i] * y[i]; }
            qq = sum8(qq);
            const float rs = rsqrtf(qq * (1.0f / 64.0f) + 64e-5f);
#pragma unroll
            for (int i = 0; i < 8; ++i) y[i] = ((y[i] * rs) * lw[i] + lb[i] + bv[i]) * g[i];
            *(u32x4*)(YA2 + (size_t)(m0 + q) * 1024 + 512 + 8 * l) = pack8(y);
        }
    }
}
#define DPP_ADD(x, ctrl) x += __builtin_bit_cast(float, __builtin_amdgcn_update_dpp(0, __builtin_bit_cast(int, x), ctrl, 0xf, 0xf, true))
__device__ __forceinline__ float rowsum16(float x) { DPP_ADD(x, 0xB1); DPP_ADD(x, 0x4E); DPP_ADD(x, 0x141); DPP_ADD(x, 0x140); return x; }
namespace scn { constexpr int CH = 32, STEP_F = 5 * 64 + 16, BUF_F = CH * STEP_F; }
__device__ __forceinline__ void phase_scan(const Frame& F) {
    using namespace scn;
#define SC_BAR() asm volatile("s_waitcnt lgkmcnt(0)\n\ts_barrier" ::: "memory")
    typedef float f32x2 __attribute__((ext_vector_type(2)));
    const bf16* RKV = (const bf16*)(F.ws + WS_RKV); const bf16* KK = (const bf16*)(F.ws + WS_KK); const bf16* BB = (const bf16*)(F.ws + WS_BB);
    const float* DEC = (const float*)(F.ws + WS_XN); bf16* Y = (bf16*)(F.ws + WS_Y);
    const int bh = F.vcu >> 2, b = bh >> 3, h = bh & 7, vq0 = (F.vcu & 3) * 16;
    const size_t mb = (size_t)b * SEQ;
    LAS float* ring = (LAS float*)F.lds;
    constexpr int NCH = SEQ / CH;
    __syncthreads();
    if (F.wave >= 4) {
        const int lt = F.tid - 256, st = lt >> 3, e8 = lt & 7;
        const bf16* pR = RKV + (mb + st) * 1536 + h * 64 + 8 * e8; const bf16* pK = pR + 512;
        const bf16* pKK = KK + (mb + st) * 512 + h * 64 + 8 * e8; const bf16* pB = BB + (mb + st) * 512 + h * 64 + 8 * e8;
        const float* pD = DEC + (mb + st) * 512 + h * 64 + 8 * e8;
        const int vs = lt >> 3, ve = (lt & 7) * 2;
        const bf16* pV = RKV + (mb + vs) * 1536 + 1024 + h * 64 + vq0 + ve;
        u32x4 gk, gb, gc, gr; f32x4 gd0, gd1; unsigned gv;
#define SC_LOAD(c) do { const size_t o_ = (size_t)(c) * CH; gk = *(const u32x4*)(pKK + o_ * 512); gb = *(const u32x4*)(pB + o_ * 512); gc = *(const u32x4*)(pK + o_ * 1536); gr = *(const u32x4*)(pR + o_ * 1536); \
            gd0 = *(const f32x4*)(pD + o_ * 512); gd1 = *(const f32x4*)(pD + o_ * 512 + 4); gv = *(const unsigned*)(pV + o_ * 1536); } while (0)
#define SC_W8(dst, q_) do { *(LAS f32x4*)(dst) = (f32x4){bflo((q_)[0]), bfhi((q_)[0]), bflo((q_)[1]), bfhi((q_)[1])}; *(LAS f32x4*)((dst) + 4) = (f32x4){bflo((q_)[2]), bfhi((q_)[2]), bflo((q_)[3]), bfhi((q_)[3])}; } while (0)
#define SC_STORE(buf) do { LAS float* d_ = ring + (buf) * BUF_F + st * STEP_F + 8 * e8; SC_W8(d_, gk); SC_W8(d_ + 64, gb); SC_W8(d_ + 128, gc); SC_W8(d_ + 192, gr); \
            *(LAS f32x4*)(d_ + 256) = gd0; *(LAS f32x4*)(d_ + 260) = gd1; LAS float* v_ = ring + (buf) * BUF_F + vs * STEP_F + 320 + ve; v_[0] = bflo(gv); v_[1] = bfhi(gv); } while (0)
        SC_LOAD(0); SC_STORE(0); SC_LOAD(1);
        SC_BAR();
        for (int c = 0; c < NCH; ++c) {
            if (c + 1 < NCH) { SC_STORE((c + 1) & 1); if (c + 2 < NCH) SC_LOAD(c + 2); }
            SC_BAR();
        }
#undef SC_LOAD
#undef SC_W8
#undef SC_STORE
    } else {
        const int rr = F.lane >> 4, kp = F.lane & 15, vl = 4 * F.wave + rr;
        bf16* pY = Y + (mb + kp) * 512 + h * 64 + vq0 + vl;
        f32x2 S01 = {0.f, 0.f}, S23 = {0.f, 0.f};
        struct StepIn { f32x4 kk, bb, kc, rc, dc; float vv; };
#define SC_RD(dst, p_, vp_) do { (dst).kk = *(const LAS f32x4*)(p_); (dst).bb = *(const LAS f32x4*)((p_) + 64); (dst).kc = *(const LAS f32x4*)((p_) + 128); (dst).rc = *(const LAS f32x4*)((p_) + 192); \
            (dst).dc = *(const LAS f32x4*)((p_) + 256); (dst).vv = *(vp_); } while (0)
#define SC_UPD(in) do { const f32x2 sa2_ = {sa_cur, sa_cur}, vv2_ = {(in).vv, (in).vv}; \
            S01 = S01 * (f32x2){(in).dc[0], (in).dc[1]} + (sa2_ * (f32x2){(in).bb[0], (in).bb[1]} + vv2_ * (f32x2){(in).kc[0], (in).kc[1]}); \
            S23 = S23 * (f32x2){(in).dc[2], (in).dc[3]} + (sa2_ * (f32x2){(in).bb[2], (in).bb[3]} + vv2_ * (f32x2){(in).kc[2], (in).kc[3]}); } while (0)
#define SC_DUAL(in_c, in_n, sidx) do { \
            const f32x2 t1_ = S01 * (f32x2){(in_c).rc[0], (in_c).rc[1]} + S23 * (f32x2){(in_c).rc[2], (in_c).rc[3]}; \
            const f32x2 t0_ = S01 * (f32x2){(in_n).kk[0], (in_n).kk[1]} + S23 * (f32x2){(in_n).kk[2], (in_n).kk[3]}; \
            float y_ = t1_[0] + t1_[1], sa_ = t0_[0] + t0_[1]; \
            DPP_ADD(sa_, 0xB1); DPP_ADD(y_, 0xB1); DPP_ADD(sa_, 0x4E); DPP_ADD(y_, 0x4E); DPP_ADD(sa_, 0x141); DPP_ADD(y_, 0x141); DPP_ADD(sa_, 0x140); DPP_ADD(y_, 0x140); \
            sa_cur = -sa_; ykeep = (kp == ((sidx) & 15)) ? y_ : ykeep; } while (0)
#define SC_SOLO_SA(in_n) do { const f32x2 t0_ = S01 * (f32x2){(in_n).kk[0], (in_n).kk[1]} + S23 * (f32x2){(in_n).kk[2], (in_n).kk[3]}; float sa_ = t0_[0] + t0_[1]; sa_cur = -rowsum16(sa_); } while (0)
#define SC_SOLO_Y(in_c, sidx) do { const f32x2 t1_ = S01 * (f32x2){(in_c).rc[0], (in_c).rc[1]} + S23 * (f32x2){(in_c).rc[2], (in_c).rc[3]}; float y_ = t1_[0] + t1_[1]; y_ = rowsum16(y_); \
            ykeep = (kp == ((sidx) & 15)) ? y_ : ykeep; } while (0)
        SC_BAR();
        float ykeep = 0.f, sa_cur = 0.f;
        for (int c = 0; c < NCH; ++c) {
            const LAS float* base = ring + (c & 1) * BUF_F + 4 * kp;
            const LAS float* vbase = ring + (c & 1) * BUF_F + 320 + vl;
            StepIn A0, A1, A2, A3, B0, B1, B2, B3;
            SC_RD(A0, base, vbase); SC_RD(A1, base + STEP_F, vbase + STEP_F); SC_RD(A2, base + 2 * STEP_F, vbase + 2 * STEP_F); SC_RD(A3, base + 3 * STEP_F, vbase + 3 * STEP_F);
            SC_SOLO_SA(A0);
#pragma unroll 1
            for (int s = 0; s < CH; s += 8) {
                const LAS float* pb = base + (s + 4) * STEP_F; const LAS float* vb_ = vbase + (s + 4) * STEP_F;
                SC_RD(B0, pb, vb_); SC_RD(B1, pb + STEP_F, vb_ + STEP_F); SC_RD(B2, pb + 2 * STEP_F, vb_ + 2 * STEP_F); SC_RD(B3, pb + 3 * STEP_F, vb_ + 3 * STEP_F);
                SC_UPD(A0); SC_DUAL(A0, A1, s); SC_UPD(A1); SC_DUAL(A1, A2, s + 1); SC_UPD(A2); SC_DUAL(A2, A3, s + 2); SC_UPD(A3); SC_DUAL(A3, B0, s + 3);
                const bool more = (s + 8 < CH);
                if (more) { const LAS float* pa = base + (s + 8) * STEP_F; const LAS float* va_ = vbase + (s + 8) * STEP_F;
                    SC_RD(A0, pa, va_); SC_RD(A1, pa + STEP_F, va_ + STEP_F); SC_RD(A2, pa + 2 * STEP_F, va_ + 2 * STEP_F); SC_RD(A3, pa + 3 * STEP_F, va_ + 3 * STEP_F); }
                SC_UPD(B0); SC_DUAL(B0, B1, s + 4); SC_UPD(B1); SC_DUAL(B1, B2, s + 5); SC_UPD(B2); SC_DUAL(B2, B3, s + 6); SC_UPD(B3);
                if (more) SC_DUAL(B3, A0, s + 7); else SC_SOLO_Y(B3, s + 7);
                if ((s & 8) != 0) pY[(size_t)(c * CH + s - 8) * 512] = (bf16)f2bf(ykeep);
            }
            SC_BAR();
        }
#undef SC_RD
#undef SC_UPD
#undef SC_DUAL
#undef SC_SOLO_SA
#undef SC_SOLO_Y
    }
}
#define CNT4_GE(c_, cand_, a0_, a1_, a2_, a3_) do { unsigned long long m0_, m1_, m2_, m3_; \
        asm volatile("v_cmp_le_u32_e64 %1, %5, %6\n\tv_cmp_le_u32_e64 %2, %5, %7\n\tv_cmp_le_u32_e64 %3, %5, %8\n\tv_cmp_le_u32_e64 %4, %5, %9\n\t" \
                     "v_addc_co_u32_e64 %0, %1, 0, %0, %1\n\tv_addc_co_u32_e64 %0, %2, 0, %0, %2\n\tv_addc_co_u32_e64 %0, %3, 0, %0, %3\n\tv_addc_co_u32_e64 %0, %4, 0, %0, %4" \
                     : "+v"(c_), "=&s"(m0_), "=&s"(m1_), "=&s"(m2_), "=&s"(m3_) : "s"(cand_), "v"(a0_), "v"(a1_), "v"(a2_), "v"(a3_)); } while (0)
__device__ __forceinline__ int wave_isum(int v) {
#define DPP_IADD(x, ctrl) x += __builtin_amdgcn_update_dpp(0, x, ctrl, 0xf, 0xf, true)
    DPP_IADD(v, 0xB1); DPP_IADD(v, 0x4E); DPP_IADD(v, 0x141); DPP_IADD(v, 0x140);
#undef DPP_IADD
    return __builtin_amdgcn_readlane(v, 0) + __builtin_amdgcn_readlane(v, 16) + __builtin_amdgcn_readlane(v, 32) + __builtin_amdgcn_readlane(v, 48);
}
__device__ __forceinline__ unsigned bs_bfi(unsigned m, unsigned a, unsigned b) { return (m & a) | (~m & b); }
template <int OFF, int N> __device__ __forceinline__ void bs_transpose32(unsigned (&a)[N]) {
#define BS_STAGE(J, M) _Pragma("unroll") for (int k0 = 0; k0 < 32; k0 += 2 * (J)) { _Pragma("unroll") for (int k1 = 0; k1 < (J); ++k1) { const int k = OFF + k0 + k1; \
        const unsigned lo = a[k], hi = a[k + (J)]; a[k] = bs_bfi((M), lo, hi << (J)); a[k + (J)] = bs_bfi((M), lo >> (J), hi); } }
    BS_STAGE(16, 0x0000FFFFu) BS_STAGE(8, 0x00FF00FFu) BS_STAGE(4, 0x0F0F0F0Fu) BS_STAGE(2, 0x33333333u) BS_STAGE(1, 0x55555555u)
#undef BS_STAGE
}
template <int NR> __device__ __forceinline__ void bs_transpose_h(unsigned (&a)[NR]) {
#define BS_STAGE(J, M) _Pragma("unroll") for (int k0 = 0; k0 < NR; k0 += 2 * (J)) { _Pragma("unroll") for (int k1 = 0; k1 < (J); ++k1) { const int k = k0 + k1; \
        const unsigned lo = a[k], hi = a[k + (J)]; a[k] = bs_bfi((M), lo, hi << (J)); a[k + (J)] = bs_bfi((M), lo >> (J), hi); } }
    if (NR == 32) { BS_STAGE(16, 0x0000FFFFu) }
    BS_STAGE(8, 0x00FF00FFu) BS_STAGE(4, 0x0F0F0F0Fu) BS_STAGE(2, 0x33333333u) BS_STAGE(1, 0x55555555u)
#undef BS_STAGE
}
__device__ __forceinline__ unsigned bs_spread16(unsigned x) { x = (x | (x << 8)) & 0x00FF00FFu; x = (x | (x << 4)) & 0x0F0F0F0Fu; x = (x | (x << 2)) & 0x33333333u; x = (x | (x << 1)) & 0x55555555u; return x; }
__device__ __forceinline__ unsigned bs_inter16(unsigned e, unsigned o) { return bs_spread16(e & 0xFFFFu) | (bs_spread16(o & 0xFFFFu) << 1); }
template <int NW> __device__ __forceinline__ void idx_select_h(const Frame& F, const unsigned* rowu, const int p, const int jng, unsigned long long* mrow) {
    constexpr int K = 32 * NW, NR = K / 2;
    const int lane = F.lane, kb = K * lane;
    unsigned a[NR];
    if (kb <= p) {
#pragma unroll
        for (int q = 0; q < NR / 4; ++q) { const u32x4 v = *(const u32x4*)(rowu + NR * lane + 4 * q);
#pragma unroll
            for (int e = 0; e < 4; ++e) { const unsigned w = v[e]; const unsigned m = (w >> 15) & 0x00010001u; a[4 * q + e] = w ^ (((m << 15) - m) | 0x80008000u); } }
    } else {
#pragma unroll
        for (int i = 0; i < NR; ++i) a[i] = 0u; }
    int nv = p - kb + 1; nv = nv < 0 ? 0 : (nv > K ? K : nv);
    const int ne = (nv + 1) >> 1, no = nv >> 1;
    const unsigned VE = ne >= 32 ? 0xFFFFFFFFu : ((1u << ne) - 1u), VO = no >= 32 ? 0xFFFFFFFFu : ((1u << no) - 1u);
    unsigned A0, A1, S0 = 0u, S1 = 0u;
    if (NW == 2) { A0 = VE; A1 = VO; } else { A0 = VE | (VO << 16); A1 = 0u; }
    bool ties = false; int need = 0;
    if (p >= 256) {
        bs_transpose_h<NR>(a);
        int G = 0; bool exact = false;
#pragma unroll
        for (int b = 15; b >= 0; --b) {
            const unsigned o0 = A0 & a[b], o1 = (NW == 2) ? (A1 & a[(NW == 2 ? 16 : 0) + b]) : 0u;
            const int t = G + wave_isum(__builtin_popcount(o0) + __builtin_popcount(o1));
            if (t >= 256) { A0 = o0; A1 = o1; if (t == 256) { exact = true; break; } }
            else { G = t; S0 |= o0; S1 |= o1; A0 ^= o0; A1 ^= o1; }
        }
        need = 256 - G;
        if (!exact) { const int ce = wave_isum(__builtin_popcount(A0) + __builtin_popcount(A1)); ties = (ce != need); }
    }
    unsigned mS_lo, mS_hi, mA_lo, mA_hi;
    if (NW == 2) { mS_lo = bs_inter16(S0, S1); mS_hi = bs_inter16(S0 >> 16, S1 >> 16); mA_lo = bs_inter16(A0, A1); mA_hi = bs_inter16(A0 >> 16, A1 >> 16); }
    else { mS_lo = bs_inter16(S0, S0 >> 16); mS_hi = 0u; mA_lo = bs_inter16(A0, A0 >> 16); mA_hi = 0u; }
    if (!ties) { mS_lo |= mA_lo; mS_hi |= mA_hi; }
    else {
        const int cl = __builtin_popcount(mA_lo) + __builtin_popcount(mA_hi); int inc = cl;
#pragma unroll
        for (int o = 1; o < 64; o <<= 1) { const int y = __shfl_up(inc, o); if (lane >= o) inc += y; }
        int r = need - (inc - cl); r = r < 0 ? 0 : (r > cl ? cl : r);
        unsigned long long x = ((unsigned long long)mA_hi << 32) | (unsigned long long)mA_lo;
        while (r > 0) { const unsigned long long low = x & (~x + 1ull); mS_lo |= (unsigned)low; mS_hi |= (unsigned)(low >> 32); x ^= low; --r; }
    }
    if (NW == 2) { if (lane < jng) mrow[(size_t)lane * SEQ] = ((unsigned long long)mS_hi << 32) | (unsigned long long)mS_lo; }
    else { if (lane < 2 * jng) ((unsigned*)(mrow + (size_t)(lane >> 1) * SEQ))[lane & 1] = mS_lo; }
}
__device__ __forceinline__ float relu1(float x) { const int i = __builtin_bit_cast(int, x); return __builtin_bit_cast(float, i > 0 ? i : 0); }
__device__ __forceinline__ void phase_idx(const Frame& F) {
    const bf16* QI = (const bf16*)(F.ws + WS_QI); const bf16* KI = (const bf16*)(F.ws + WS_KI); const float* WI = (const float*)(F.ws + WS_WI);
    unsigned* SCRU = (unsigned*)(F.ws + WS_SCR) + (size_t)F.vcu * (32 * (SEQ / 2)); unsigned long long* MASK = (unsigned long long*)(F.ws + WS_MASK);
    const int lane = F.lane, wave = F.wave, r = lane & 31, hh = lane >> 5, g_ = r >> 2;
    const int qsel = 2 * (g_ & 1) + (g_ >> 2), hsel = 4 * ((g_ >> 1) & 1) + (r & 3);
    const int b = F.vcu >> 5, ii = F.vcu & 31;
    for (int gi = 0; gi < 4; ++gi) {
        const int g = gi == 0 ? ii : (gi == 1 ? 63 - ii : (gi == 2 ? 64 + ii : 127 - ii));
        const int p0 = 32 * g; const size_t mb = (size_t)b * SEQ; const size_t mq = mb + p0 + 4 * wave;
        bf16x8 a[4];
#pragma unroll
        for (int ks = 0; ks < 4; ++ks) a[ks] = *(const bf16x8*)(QI + (mq + qsel) * 512 + hsel * 64 + 16 * ks + 8 * hh);
        float wv[16];
#pragma unroll
        for (int qq = 0; qq < 2; ++qq) { const f32x4 w0 = *(const f32x4*)(WI + (mq + 2 * hh + qq) * 8), w1 = *(const f32x4*)(WI + (mq + 2 * hh + qq) * 8 + 4);
            wv[8 * qq + 0] = w0[0]; wv[8 * qq + 1] = w0[1]; wv[8 * qq + 2] = w0[2]; wv[8 * qq + 3] = w0[3]; wv[8 * qq + 4] = w1[0]; wv[8 * qq + 5] = w1[1]; wv[8 * qq + 6] = w1[2]; wv[8 * qq + 7] = w1[3]; }
        unsigned* srow = SCRU + (size_t)(4 * wave + 2 * hh) * (SEQ / 2);
        const int nkt = g + 1, nch = (nkt + 7) >> 3;
        const int skey = F.tid >> 3, sc = F.tid & 7;
        const bf16* ksrc = KI + (mb + skey) * 64 + 8 * sc;
        u32x4 st[4];
#define IDX_LOAD(ch) _Pragma("unroll") for (int i_ = 0; i_ < 4; ++i_) st[i_] = *(const u32x4*)(ksrc + (size_t)((ch) * 256 + 64 * i_) * 64)
#define IDX_STORE(buf) _Pragma("unroll") for (int i_ = 0; i_ < 4; ++i_) { const int row_ = 64 * i_ + 32 * (skey & 1) + (skey >> 1);     \
            *(LAS u32x4*)(F.lds + (buf) * 32768 + row_ * 128 + ((sc ^ ((row_ >> 1) & 7)) << 4)) = st[i_]; }
#define IDX_BAR() asm volatile("s_waitcnt lgkmcnt(0)\n\ts_barrier" ::: "memory")
        IDX_LOAD(0);
        IDX_BAR();
        IDX_STORE(0);
        if (nch > 1) IDX_LOAD(1);
        for (int ch = 0; ch < nch; ++ch) {
            IDX_BAR();
            const LAS unsigned char* cb = F.lds + (ch & 1) * 32768;
            bf16x8 bfA[2][4], bfB[2][4]; f32x16 accA[2], accB[2];
#define IDX_READ(bf_, tb_) _Pragma("unroll") for (int t2 = 0; t2 < 2; ++t2) { const int key = 32 * ((tb_) + t2) + r; const LAS unsigned char* kb = cb + key * 128; const int sw = (key >> 1) & 7; \
                _Pragma("unroll") for (int ks = 0; ks < 4; ++ks) bf_[t2][ks] = *(const LAS bf16x8*)(kb + (((2 * ks + hh) ^ sw) << 4)); }
#define IDX_MMA(acc_, bf_) { _Pragma("unroll") for (int t2 = 0; t2 < 2; ++t2) acc_[t2] = (f32x16){0.f, 0.f, 0.f, 0.f, 0.f, 0.f, 0.f, 0.f, 0.f, 0.f, 0.f, 0.f, 0.f, 0.f, 0.f, 0.f}; \
                _Pragma("unroll") for (int ks = 0; ks < 4; ++ks) { _Pragma("unroll") for (int t2 = 0; t2 < 2; ++t2) acc_[t2] = __builtin_amdgcn_mfma_f32_32x32x16_bf16(a[ks], bf_[t2][ks], acc_[t2], 0, 0, 0); } }
#define IDX_EPI(acc_, tb_) { float s_[2][2]; _Pragma("unroll") for (int t2 = 0; t2 < 2; ++t2) { float s0 = 0.f, s1 = 0.f; \
                _Pragma("unroll") for (int hd = 0; hd < 8; ++hd) { s0 += wv[hd] * relu1(acc_[t2][hd]); s1 += wv[8 + hd] * relu1(acc_[t2][8 + hd]); } s_[t2][0] = s0; s_[t2][1] = s1; } \
                const int ui = 128 * ch + 16 * (tb_) + r;                \
                srow[ui] = __builtin_bit_cast(unsigned, __builtin_amdgcn_cvt_pkrtz(s_[0][0], s_[1][0])); srow[SEQ / 2 + ui] = __builtin_bit_cast(unsigned, __builtin_amdgcn_cvt_pkrtz(s_[0][1], s_[1][1])); }
            IDX_READ(bfA, 0)
            IDX_MMA(accA, bfA) IDX_READ(bfB, 2)
            IDX_MMA(accB, bfB) IDX_READ(bfA, 4) IDX_EPI(accA, 0)
            IDX_MMA(accA, bfA) IDX_READ(bfB, 6) IDX_EPI(accB, 2)
            IDX_MMA(accB, bfB) IDX_EPI(accA, 4)
            IDX_EPI(accB, 6)
#undef IDX_READ
#undef IDX_MMA
#undef IDX_EPI
            if (ch + 1 < nch) { IDX_STORE((ch + 1) & 1); if (ch + 2 < nch) IDX_LOAD(ch + 2); }
        }
#undef IDX_LOAD
#undef IDX_STORE
#undef IDX_BAR
        asm volatile("s_waitcnt vmcnt(0)\n\tbuffer_inv sc1" ::: "memory");
        const int jng = ((p0 + 31) >> 6) + 1;
        if (jng <= 32) {
#pragma unroll 1
            for (int i = 0; i < 4; ++i) { const int p = p0 + 4 * wave + i; idx_select_h<1>(F, SCRU + (size_t)(4 * wave + i) * (SEQ / 2), p, jng, MASK + (size_t)(b * 64) * SEQ + p); }
        } else {
#pragma unroll 1
            for (int i = 0; i < 4; ++i) { const int p = p0 + 4 * wave + i; idx_select_h<2>(F, SCRU + (size_t)(4 * wave + i) * (SEQ / 2), p, jng, MASK + (size_t)(b * 64) * SEQ + p); }
        }
        asm volatile("s_waitcnt vmcnt(0)" ::: "memory");
    }
}
namespace att {
constexpr int L_K = 0, L_V = 16384, L_WS = 32768, L_OST = L_WS + 8 * 256, L_BT = L_OST + 8 * 4096, L_LUT = L_BT + 512, L_END = L_LUT + 256;
__device__ __forceinline__ int crow(int r, int hi) { return (r & 3) + 8 * (r >> 2) + 4 * hi; }
typedef float f32x2_t __attribute__((ext_vector_type(2))); typedef __bf16 bf16x2_t __attribute__((ext_vector_type(2)));
__device__ __forceinline__ unsigned cvtpk(float lo, float hi) { f32x2_t v = {lo, hi}; bf16x2_t b = __builtin_convertvector(v, bf16x2_t); return __builtin_bit_cast(unsigned, b); }
__device__ __forceinline__ int t5_bucket(int d) {
    if (d < 16) return d;
    return 16 + (d >= 19) + (d >= 21) + (d >= 24) + (d >= 27) + (d >= 31) + (d >= 35) + (d >= 40) + (d >= 46) + (d >= 52) + (d >= 59) + (d >= 67) + (d >= 77) + (d >= 87) + (d >= 99) + (d >= 113);
}
}
__device__ __forceinline__ void phase_attn(const Frame& F) {
    using namespace att;
    const bf16* Qg = (const bf16*)(F.ws + WS_Q); const bf16* Kg = (const bf16*)(F.ws + WS_K); const bf16* Vg = (const bf16*)(F.ws + WS_V); bf16* Og = (bf16*)(F.ws + WS_YA2);
    const unsigned long long* MASK = (const unsigned long long*)(F.ws + WS_MASK); const float* relb = F.in[5];
    const int tid = F.tid, lane = F.lane, wid = F.wave, r32 = lane & 31, hi = lane >> 5;
    const int bh = F.vcu >> 2, b = bh >> 3, h = bh & 7, sx = F.vcu & 3;
    LAS unsigned char* lds = F.lds;
    LAS float* btab = (LAS float*)(lds + L_BT);
    LAS float* wsf = (LAS float*)(lds + L_WS) + wid * 64;
#define ATT_BAR() asm volatile("s_waitcnt lgkmcnt(0)\n\ts_barrier" ::: "memory")
    __syncthreads();
    if (tid < 128) { const int bk = t5_bucket(tid); btab[tid] = (relb[bk * 8 + h] - relb[31 * 8 + h]) * LOG2E; }
    if (tid < 64) ((LAS float*)(lds + L_LUT))[tid] = (((tid >> 2) >> (tid & 3)) & 1) ? 0.f : -1.0e30f;
    const unsigned lutb = (unsigned)(uintptr_t)(lds + L_LUT);
    const size_t mb = (size_t)b * SEQ;
    const unsigned vb0 = (unsigned)(uintptr_t)(lds + L_V) + ((lane >> 4) & 1) * 32 + (lane & 3) * 8 + (4 * hi + ((lane & 15) >> 2)) * 64;
    for (int ui = 0; ui < 4; ++ui) {
        const int qb = ui == 0 ? sx : (ui == 1 ? 7 - sx : (ui == 2 ? 8 + sx : 15 - sx));
        const int q0 = 256 * qb, qw = q0 + 32 * wid;
        const bf16* Qw = Qg + (mb + qw) * 512 + h * 64;
        bf16x8 qr[4];
#pragma unroll
        for (int d0 = 0; d0 < 4; ++d0) qr[d0] = *(const bf16x8*)(Qw + (size_t)r32 * 512 + d0 * 16 + hi * 8);
        f32x16 o0 = {0.f, 0.f, 0.f, 0.f, 0.f, 0.f, 0.f, 0.f, 0.f, 0.f, 0.f, 0.f, 0.f, 0.f, 0.f, 0.f}, o1 = o0, osum = o0;
        const int NT = 4 * qb + 4, ktw = (qw + 31) >> 6;
        const bf16* ksrc = Kg + (mb + lane) * 512 + h * 64 + wid * 8;
        const bf16* vsrc = Vg + (mb + 16 * (wid & 3) + (lane >> 2)) * 512 + h * 64 + (wid >> 2) * 32 + (lane & 3) * 8;
        const unsigned long long* msrc = MASK + (size_t)(b * 64) * SEQ + qw + r32;
        u32x4 kreg = *(const u32x4*)ksrc, vreg = *(const u32x4*)vsrc;
        unsigned long long mw = msrc[0];
        ATT_BAR();
        *(LAS u32x4*)(lds + L_K + wid * 1024 + lane * 16) = kreg; *(LAS u32x4*)(lds + L_V + wid * 1024 + lane * 16) = vreg;
        kreg = *(const u32x4*)(ksrc + (size_t)64 * 512); vreg = *(const u32x4*)(vsrc + (size_t)64 * 512);
        for (int kt = 0; kt < NT; ++kt) {
            const int bo = (kt & 1) * 8192;
            ATT_BAR();
            unsigned long long mwn = 0ull;
            if (kt + 1 <= ktw) mwn = msrc[(size_t)(kt + 1) * SEQ];
            if (kt <= ktw) {
                f32x16 p0, p1;
                { const unsigned al = ((unsigned)mw >> (4 * hi) & 0x0F0F0F0Fu) << 4, ah = ((unsigned)(mw >> 32) >> (4 * hi) & 0x0F0F0F0Fu) << 4;
#pragma unroll
                  for (int g4 = 0; g4 < 4; ++g4) {
                      const f32x4 t0 = *(const LAS f32x4*)(uintptr_t)(lutb + ((al >> (8 * g4)) & 0xFFu)), t1 = *(const LAS f32x4*)(uintptr_t)(lutb + ((ah >> (8 * g4)) & 0xFFu));
                      p0[4 * g4] = t0[0]; p0[4 * g4 + 1] = t0[1]; p0[4 * g4 + 2] = t0[2]; p0[4 * g4 + 3] = t0[3];
                      p1[4 * g4] = t1[0]; p1[4 * g4 + 1] = t1[1]; p1[4 * g4 + 2] = t1[2]; p1[4 * g4 + 3] = t1[3]; } }
                const LAS unsigned char* kb = lds + L_K + bo + hi * 1024 + r32 * 16;
#pragma unroll
                for (int d0 = 0; d0 < 4; ++d0) { const bf16x8 b0 = *(const LAS bf16x8*)(kb + d0 * 2048), b1 = *(const LAS bf16x8*)(kb + d0 * 2048 + 512);
                    p0 = __builtin_amdgcn_mfma_f32_32x32x16_bf16(b0, qr[d0], p0, 0, 0, 0); p1 = __builtin_amdgcn_mfma_f32_32x32x16_bf16(b1, qr[d0], p1, 0, 0, 0); }
                if (64 * kt + 63 + 112 >= qw) {
                    const int dbase = qw + r32 - 64 * kt - 4 * hi;
#pragma unroll
                    for (int r = 0; r < 16; ++r) { const int c = (r & 3) + 8 * (r >> 2); int d0_ = dbase - c, d1_ = d0_ - 32;
                        d0_ = d0_ < 0 ? 0 : (d0_ > 127 ? 127 : d0_); d1_ = d1_ < 0 ? 0 : (d1_ > 127 ? 127 : d1_); p0[r] += btab[d0_]; p1[r] += btab[d1_]; }
                }
#pragma unroll
                for (int r = 0; r < 16; ++r) { p0[r] = __builtin_amdgcn_exp2f(p0[r]); p1[r] = __builtin_amdgcn_exp2f(p1[r]); }
                u32x4 pw0, pw1, pw2, pw3;
                pw0 = (u32x4){cvtpk(p0[0], p0[1]), cvtpk(p0[2], p0[3]), cvtpk(p0[4], p0[5]), cvtpk(p0[6], p0[7])};
                pw1 = (u32x4){cvtpk(p0[8], p0[9]), cvtpk(p0[10], p0[11]), cvtpk(p0[12], p0[13]), cvtpk(p0[14], p0[15])};
                pw2 = (u32x4){cvtpk(p1[0], p1[1]), cvtpk(p1[2], p1[3]), cvtpk(p1[4], p1[5]), cvtpk(p1[6], p1[7])};
                pw3 = (u32x4){cvtpk(p1[8], p1[9]), cvtpk(p1[10], p1[11]), cvtpk(p1[12], p1[13]), cvtpk(p1[14], p1[15])};
                const bf16x8 pa0 = __builtin_bit_cast(bf16x8, pw0), pa1 = __builtin_bit_cast(bf16x8, pw1), pa2 = __builtin_bit_cast(bf16x8, pw2), pa3 = __builtin_bit_cast(bf16x8, pw3);
                { const bf16x8 ones = {(short)0x3F80, (short)0x3F80, (short)0x3F80, (short)0x3F80, (short)0x3F80, (short)0x3F80, (short)0x3F80, (short)0x3F80};
                  osum = __builtin_amdgcn_mfma_f32_32x32x16_bf16(pa0, ones, osum, 0, 0, 0); osum = __builtin_amdgcn_mfma_f32_32x32x16_bf16(pa1, ones, osum, 0, 0, 0);
                  osum = __builtin_amdgcn_mfma_f32_32x32x16_bf16(pa2, ones, osum, 0, 0, 0); osum = __builtin_amdgcn_mfma_f32_32x32x16_bf16(pa3, ones, osum, 0, 0, 0); }
                const unsigned vb = vb0 + bo;
#pragma unroll
                for (int d0 = 0; d0 < 2; ++d0) { s16x4 lo[4], hv[4];
#pragma unroll
                    for (int ks = 0; ks < 4; ++ks) {
                        asm volatile("ds_read_b64_tr_b16 %0,%1 offset:%c2" : "=&v"(lo[ks]) : "v"(vb), "i"(d0 * 4096 + ks * 1024) : "memory");
                        asm volatile("ds_read_b64_tr_b16 %0,%1 offset:%c2" : "=&v"(hv[ks]) : "v"(vb), "i"(d0 * 4096 + ks * 1024 + 512) : "memory"); }
                    asm volatile("s_waitcnt lgkmcnt(0)" ::: "memory"); __builtin_amdgcn_sched_barrier(0);
#define PKV(k) (bf16x8){lo[k][0], lo[k][1], lo[k][2], lo[k][3], hv[k][0], hv[k][1], hv[k][2], hv[k][3]}
                    f32x16 oo = d0 == 0 ? o0 : o1;
                    oo = __builtin_amdgcn_mfma_f32_32x32x16_bf16(pa0, PKV(0), oo, 0, 0, 0); oo = __builtin_amdgcn_mfma_f32_32x32x16_bf16(pa1, PKV(1), oo, 0, 0, 0);
                    oo = __builtin_amdgcn_mfma_f32_32x32x16_bf16(pa2, PKV(2), oo, 0, 0, 0); oo = __builtin_amdgcn_mfma_f32_32x32x16_bf16(pa3, PKV(3), oo, 0, 0, 0);
                    if (d0 == 0) o0 = oo; else o1 = oo;
#undef PKV
                }
            }
            mw = mwn;
            if (kt + 1 < NT) {
                const int bn = ((kt + 1) & 1) * 8192;
                *(LAS u32x4*)(lds + L_K + bn + wid * 1024 + lane * 16) = kreg; *(LAS u32x4*)(lds + L_V + bn + wid * 1024 + lane * 16) = vreg;
                if (kt + 2 < NT) { kreg = *(const u32x4*)(ksrc + (size_t)(kt + 2) * 64 * 512); vreg = *(const u32x4*)(vsrc + (size_t)(kt + 2) * 64 * 512); }
            }
        }
        float rli[16];
#pragma unroll
        for (int r = 0; r < 16; ++r) rli[r] = __builtin_amdgcn_rcpf(osum[r]);
        bf16* Ow = Og + (mb + qw) * 1024 + h * 64;
        LAS bf16* stg = (LAS bf16*)(lds + L_OST) + wid * 2048;
#pragma unroll
        for (int r = 0; r < 16; ++r) { const int orow = crow(r, hi); stg[orow * 64 + r32] = (bf16)f2bf(o0[r] * rli[r]); stg[orow * 64 + 32 + r32] = (bf16)f2bf(o1[r] * rli[r]); }
        asm volatile("s_waitcnt lgkmcnt(0)" ::: "memory");
#pragma unroll
        for (int i = 0; i < 4; ++i) { const int row = i * 8 + (lane >> 3), ch = lane & 7; const u32x4 v = *(const LAS u32x4*)(stg + row * 64 + ch * 8); *(u32x4*)(Ow + (size_t)row * 1024 + ch * 8) = v; }
        asm volatile("s_waitcnt lgkmcnt(0)" ::: "memory");
    }
    __syncthreads();
#undef ATT_BAR
}
namespace rc {
constexpr int PB = 72;
constexpr int MB = 64 * PB * 2;
constexpr int O_KG = 0, O_RG = MB, O_BN = 2 * MB, O_KN = 3 * MB;
constexpr int O_BET = 4 * MB, O_KET = 5 * MB, O_VT = 6 * MB;
constexpr int O_AKK = 7 * MB, O_ARB = 8 * MB, O_ARK = 9 * MB;
constexpr int O_WT = 10 * MB, O_UT = 11 * MB;
constexpr int O_AKB = 12 * MB;
constexpr int PF2 = 65;
constexpr int O_F1 = 13 * MB;
constexpr int O_F2 = O_F1 + 64 * 16 * 4;
constexpr int O_G63 = O_F2 + 64 * PF2 * 4;
constexpr int O_TI = O_G63 + 512;
constexpr int O_RT = O_TI + 4 * 16 * 64;
constexpr int O_END = O_RT + 2 * 64 * 64;
static_assert(O_END <= LDS_BYTES - 512, "RC1 LDS map");
typedef float f32x4v __attribute__((ext_vector_type(4)));
__device__ __forceinline__ f32x4v mma(bf16x8 a, bf16x8 b, f32x4v c) { return __builtin_amdgcn_mfma_f32_16x16x32_bf16(a, b, c, 0, 0, 0); }
__device__ __forceinline__ f32x4v tile(const LAS unsigned char* A, const LAS unsigned char* Bt, int rt, int ct, int fr, int fq, f32x4v acc) {
    const LAS unsigned char* pa = A + ((16 * rt + fr) * PB + 8 * fq) * 2; const LAS unsigned char* pb = Bt + ((16 * ct + fr) * PB + 8 * fq) * 2;
    acc = mma(*(const LAS bf16x8*)pa, *(const LAS bf16x8*)pb, acc);
    acc = mma(*(const LAS bf16x8*)(pa + 64), *(const LAS bf16x8*)(pb + 64), acc);
    return acc;
}
template <bool SA, bool SB> __device__ __forceinline__ f32x4v tileS(const LAS unsigned char* A, const LAS unsigned char* Bt, int rt, int ct, int fr, int fq, f32x4v acc) {
    const int ra = 16 * rt + fr, rb = 16 * ct + fr; const int sa = SA ? ((ra >> 3) & 7) : 0, sb = SB ? ((rb >> 3) & 7) : 0;
    const LAS unsigned char* pa = A + ra * PB * 2; const LAS unsigned char* pb = Bt + rb * PB * 2;
    acc = mma(*(const LAS bf16x8*)(pa + ((fq ^ sa) << 4)), *(const LAS bf16x8*)(pb + ((fq ^ sb) << 4)), acc);
    acc = mma(*(const LAS bf16x8*)(pa + (((fq + 4) ^ sa) << 4)), *(const LAS bf16x8*)(pb + (((fq + 4) ^ sb) << 4)), acc);
    return acc;
}
}
__device__ __forceinline__ void phase_rc1(const Frame& F) {
    using namespace rc;
    const bf16* Z = (const bf16*)(F.ws + WS_Z); const bf16* AA = (const bf16*)(F.ws + WS_AA); bf16* BVg = (bf16*)(F.ws + WS_BV);
    const float* LD = (const float*)(F.ws + WS_XN); bf16* RWg = (bf16*)(F.ws + WS_RW); bf16* Y0g = (bf16*)(F.ws + WS_Y0); bf16* Pg = (bf16*)(F.ws + WS_P); bf16* QTg = (bf16*)(F.ws + WS_QT);
    LAS unsigned char* L = F.lds; LAS float* F1 = (LAS float*)(L + O_F1); LAS float* F2 = (LAS float*)(L + O_F2); LAS float* G63 = (LAS float*)(L + O_G63);
    const int tid = F.tid, lane = F.lane, wave = F.wave, fr = lane & 15, fq = lane >> 4;
    const int t = tid >> 3, c8 = tid & 7;
    __syncthreads();
    for (int i = tid; i < (4 * 16 * 64 + 2 * 64 * 64) / 16; i += 512) *(LAS u32x4*)(L + O_TI + 16 * i) = (u32x4){0u, 0u, 0u, 0u};
    const int bh = F.vcu >> 2, b = bh >> 3, h = bh & 7;
    struct RcIn { f32x4 l0, l1, t0, t1; };
#define RC_LOADIN(x_, ch_) { const size_t mr_ = (size_t)b * SEQ + 64 * (ch_) + t; \
        x_.l0 = *(const f32x4*)(LD + mr_ * 512 + h * 64 + 8 * c8); x_.l1 = *(const f32x4*)(LD + mr_ * 512 + h * 64 + 8 * c8 + 4); \
        const float* ts_ = LD + ((size_t)b * SEQ + 64 * (ch_) + lane) * 512 + h * 64 + 8 * wave; x_.t0 = *(const f32x4*)ts_; x_.t1 = *(const f32x4*)(ts_ + 4); }
    RcIn cur, nxt; RC_LOADIN(cur, (F.vcu & 3))
    for (int j = 0; j < 16; ++j) {
        const int ch = (F.vcu & 3) + 4 * j, u = bh * 64 + ch; const size_t m0 = (size_t)b * SEQ + 64 * ch;
        bf16* rwu = RWg + (size_t)u * 4096; bf16* y0u = Y0g + (size_t)u * 4096; bf16* pu = Pg + (size_t)u * 4096; bf16* qtu = QTg + (size_t)u * 4096;
        const size_t mrow = m0 + t;
        const bf16* zrow = Z + mrow * RWW + h * 64 + 8 * c8;
        const u32x4 wr_ = *(const u32x4*)(zrow), wk_ = *(const u32x4*)(zrow + 512), wv_ = *(const u32x4*)(zrow + 1024);
        u32x4 pr_ = (u32x4){0u, 0u, 0u, 0u}, pk_ = pr_, pv_ = pr_;
        if ((ch | t) != 0) { pr_ = *(const u32x4*)(zrow - RWW); pk_ = *(const u32x4*)(zrow - RWW + 512); pv_ = *(const u32x4*)(zrow - RWW + 1024); }
        const u32x4 wa_ = *(const u32x4*)(AA + mrow * 512 + h * 64 + 8 * c8);
        float mur[8], muk[8], muv_[8], kkw[8], kaw[8], rkw[8];
        ld8f(F.in[6] + h * 64 + 8 * c8, mur); ld8f(F.in[6] + 512 + h * 64 + 8 * c8, muk); ld8f(F.in[6] + 1024 + h * 64 + 8 * c8, muv_);
        ld8f(F.in[12] + h * 64 + 8 * c8, kkw); ld8f(F.in[13] + h * 64 + 8 * c8, kaw); ld8f(F.in[14] + h * 64 + 8 * c8, rkw);
        float ld[8]; ld[0] = cur.l0[0]; ld[1] = cur.l0[1]; ld[2] = cur.l0[2]; ld[3] = cur.l0[3]; ld[4] = cur.l1[0]; ld[5] = cur.l1[1]; ld[6] = cur.l1[2]; ld[7] = cur.l1[3];
        LAS float* G63p = G63 + (j & 1) * 64;
        { float xs[8] = {cur.t0[0], cur.t0[1], cur.t0[2], cur.t0[3], cur.t1[0], cur.t1[1], cur.t1[2], cur.t1[3]};
#pragma unroll
          for (int i = 0; i < 8; ++i) { float x = xs[i];
#define RC_SCAN(ctrl, rm) x += __builtin_bit_cast(float, __builtin_amdgcn_update_dpp(0, __builtin_bit_cast(int, x), ctrl, rm, 0xf, false))
              RC_SCAN(0x111, 0xf); RC_SCAN(0x112, 0xf); RC_SCAN(0x114, 0xf); RC_SCAN(0x118, 0xf); RC_SCAN(0x142, 0xa); RC_SCAN(0x143, 0xc);
#undef RC_SCAN
              F2[lane * PF2 + 8 * wave + i] = x; if (lane == 63) G63p[8 * wave + i] = x; } }
        __syncthreads();
        { float r[8], k[8], v[8], kk[8], bb[8], aa[8]; unpack8(wr_, r); unpack8(wk_, k); unpack8(wv_, v); unpack8(wa_, aa);
          { float q_[8];
            unpack8(pr_, q_);
#pragma unroll
            for (int i = 0; i < 8; ++i) r[i] = r[i] + mur[i] * (q_[i] - r[i]);
            unpack8(pk_, q_);
#pragma unroll
            for (int i = 0; i < 8; ++i) k[i] = k[i] + muk[i] * (q_[i] - k[i]);
            unpack8(pv_, q_);
#pragma unroll
            for (int i = 0; i < 8; ++i) v[i] = v[i] + muv_[i] * (q_[i] - v[i]); }
          { float ss = 0.f;
#pragma unroll
            for (int i = 0; i < 8; ++i) { kk[i] = k[i] * kkw[i]; ss += kk[i] * kk[i]; }
            ss = sum8(ss); const float inv = 1.0f / fmaxf(sqrtf(ss), 1e-12f);
#pragma unroll
            for (int i = 0; i < 8; ++i) { kk[i] *= inv; bb[i] = kk[i] * aa[i]; k[i] = k[i] * (1.0f + (aa[i] - 1.0f) * kaw[i]); } }
          { float dt = 0.f;
#pragma unroll
            for (int i = 0; i < 8; ++i) dt += r[i] * k[i] * rkw[i];
            dt = sum8(dt); float bv[8];
#pragma unroll
            for (int i = 0; i < 8; ++i) bv[i] = dt * v[i];
            *(u32x4*)(BVg + mrow * 512 + h * 64 + 8 * c8) = pack8(bv); }
          float kg[8], rg[8], bn[8], kn[8], be[8], ke[8];
#pragma unroll
          for (int i = 0; i < 8; ++i) { const float g = F2[t * PF2 + 8 * c8 + i], g63 = G63p[8 * c8 + i];
              const float eg = __expf(g), egp = __expf(g - ld[i]), en = __expf(-g), ee = __expf(g63 - g);
              kg[i] = kk[i] * egp; rg[i] = r[i] * eg; bn[i] = bb[i] * en; kn[i] = k[i] * en; be[i] = bb[i] * ee; ke[i] = k[i] * ee; }
          const int ro = (t * PB + 8 * c8) * 2;
          *(LAS u32x4*)(L + O_KG + ro) = pack8(kg); *(LAS u32x4*)(L + O_RG + ro) = pack8(rg); *(LAS u32x4*)(L + O_BN + ro) = pack8(bn); *(LAS u32x4*)(L + O_KN + ro) = pack8(kn);
#pragma unroll
          for (int i = 0; i < 8; ++i) { const int to = ((8 * c8 + i) * PB + ((((t >> 3) ^ c8) << 3) | (t & 7))) * 2;
              *(LAS bf16*)(L + O_BET + to) = (bf16)f2bf(be[i]); *(LAS bf16*)(L + O_KET + to) = (bf16)f2bf(ke[i]); *(LAS bf16*)(L + O_VT + to) = (bf16)f2bf(v[i]); } }
        for (int i = tid; i < 2 * MB / 16; i += 512) *(LAS u32x4*)(L + O_WT + 16 * i) = (u32x4){0u, 0u, 0u, 0u};
        __syncthreads();
        { const int rt = wave & 3; const bool isR = wave >= 4; const LAS unsigned char* Am = L + (isR ? O_RG : O_KG);
#pragma unroll
          for (int ct8 = 0; ct8 < 8; ++ct8) { const int ct = ct8 & 3; const bool isK = ct8 >= 4;
              f32x4v acc = {0.f, 0.f, 0.f, 0.f}; acc = tile(Am, L + (isK ? O_KN : O_BN), rt, ct, fr, fq, acc);
              const int j = 16 * ct + fr;
#pragma unroll
              for (int i = 0; i < 4; ++i) { const int tt = 16 * rt + 4 * fq + i; const bool keep = isR ? (j <= tt) : (j < tt); const float val = keep ? acc[i] : 0.f;
                  if (!isR && !isK && rt == ct) F1[tt * 16 + (j & 15)] = val;
                  *(LAS bf16*)(L + (isR ? (isK ? O_ARK : O_ARB) : (isK ? O_AKK : O_AKB)) + (tt * PB + j) * 2) = (bf16)f2bf(val); } } }
        __syncthreads();
        { const int rt = wave >> 1;
#pragma unroll
          for (int cc = 0; cc < 2; ++cc) { const int ct = 2 * (wave & 1) + cc; f32x4v acc = {0.f, 0.f, 0.f, 0.f}; acc = tileS<false, true>(L + O_AKK, L + O_VT, rt, ct, fr, fq, acc);
#pragma unroll
              for (int i = 0; i < 4; ++i) F2[(16 * rt + 4 * fq + i) * PF2 + 16 * ct + fr] = acc[i]; } }
        if (wave >= 2 && wave < 6) {
            const int blk = wave - 2, cidx = lane & 15; const LAS float* cb = F1 + blk * 256; asm volatile("" : "+v"(cb));
            float x[16]; f32x4 ce[4], co[4];
#define RC_FETCH(i_, C_) { _Pragma("unroll") for (int j4 = 0; j4 < ((i_) + 3) / 4; ++j4) C_[j4] = *(volatile const LAS f32x4*)(cb + (i_) * 16 + 4 * j4); }
#define RC_SOLVE(i_, C_) { float acc_ = (cidx == (i_)) ? 1.0f : 0.0f; \
                _Pragma("unroll") for (int j4 = 0; j4 < ((i_) + 3) / 4; ++j4) { _Pragma("unroll") for (int e = 0; e < 4; ++e) if (4 * j4 + e < (i_)) acc_ -= C_[j4][e] * x[4 * j4 + e]; } \
                asm volatile("" : "+v"(acc_)); x[i_] = acc_; }
#define RC_ROW2(i_) { RC_FETCH((i_) + 1, co) RC_SOLVE((i_), ce) if ((i_) + 2 < 16) RC_FETCH((i_) + 2, ce) RC_SOLVE((i_) + 1, co) }
            RC_FETCH(0, ce)
            RC_ROW2(0) RC_ROW2(2) RC_ROW2(4) RC_ROW2(6) RC_ROW2(8) RC_ROW2(10) RC_ROW2(12) RC_ROW2(14)
#undef RC_ROW2
#undef RC_SOLVE
#undef RC_FETCH
            if (lane < 16) {
#pragma unroll
                for (int i = 0; i < 16; ++i) *(LAS bf16*)(L + O_TI + ((blk * 16 + i) * 32 + cidx) * 2) = (bf16)f2bf(x[i]); }
        }
        __syncthreads();
        {
            const int mat = wave >> 2, ct = wave & 3;
            LAS unsigned char* XT = L + (mat == 0 ? O_WT : O_UT); LAS unsigned char* RT = L + O_RT + mat * 4096;
            const int c = 16 * ct + fr;
#pragma unroll 1
            for (int blk = 0; blk < 4; ++blk) {
                { f32x4v acc = {0.f, 0.f, 0.f, 0.f}; acc = tile(L + O_AKB, XT, blk, ct, fr, fq, acc);
                    const int t0 = 16 * blk + 4 * fq; float rv[4];
                    if (mat == 0) {
#pragma unroll
                        for (int i = 0; i < 4; ++i) rv[i] = bflo((unsigned)*(const LAS bf16*)(L + O_KG + ((t0 + i) * PB + c) * 2));
                    } else {
#pragma unroll
                        for (int i = 0; i < 4; ++i) rv[i] = F2[(t0 + i) * PF2 + c]; }
                    u32x2 w; w.x = pk2(rv[0] - acc[0], rv[1] - acc[1]); w.y = pk2(rv[2] - acc[2], rv[3] - acc[3]);
                    *(LAS u32x2*)(RT + (c * 32 + 4 * fq) * 2) = w; }
                asm volatile("s_waitcnt lgkmcnt(0)" ::: "memory");
                const bf16x8 ta = *(const LAS bf16x8*)(L + O_TI + ((blk * 16 + fr) * 32 + 8 * fq) * 2);
                { f32x4v acc = {0.f, 0.f, 0.f, 0.f};
                    acc = mma(ta, *(const LAS bf16x8*)(RT + (c * 32 + 8 * fq) * 2), acc);
                    u32x2 w; w.x = pk2(acc[0], acc[1]); w.y = pk2(acc[2], acc[3]);
                    *(LAS u32x2*)(XT + (c * PB + 16 * blk + 4 * fq) * 2) = w; }
                asm volatile("s_waitcnt lgkmcnt(0)" ::: "memory");
            }
        }
        __syncthreads();
        if (j + 1 < 16) RC_LOADIN(nxt, ch + 4)
        { const int mtx = wave >> 1, hf = wave & 1;
#pragma unroll 1
          for (int rr = 0; rr < 2; ++rr) { const int rt = 2 * hf + rr;
#pragma unroll 2
              for (int ct = 0; ct < 4; ++ct) {
                  const int col = 16 * ct + fr, row0 = 16 * rt + 4 * fq;
                  f32x4v acc = {0.f, 0.f, 0.f, 0.f};
                  if (mtx == 0) {
                      acc = tile(L + O_WT, L + O_ARB, rt, ct, fr, fq, acc);
                      const unsigned long long rgw = *(const LAS unsigned long long*)(L + O_RG + (col * PB + row0) * 2);
                      const float o0 = bflo((unsigned)rgw) - acc[0], o1 = bfhi((unsigned)rgw) - acc[1], o2 = bflo((unsigned)(rgw >> 32)) - acc[2], o3 = bfhi((unsigned)(rgw >> 32)) - acc[3];
                      u32x2 w; w.x = pk2(o0, o1); w.y = pk2(o2, o3); *(u32x2*)(rwu + col * 64 + row0) = w;
                  } else if (mtx == 1) {
                      acc = tileS<true, false>(L + O_VT, L + O_ARK, rt, ct, fr, fq, acc); f32x4v a2 = {0.f, 0.f, 0.f, 0.f}; a2 = tile(L + O_UT, L + O_ARB, rt, ct, fr, fq, a2);
                      { u32x2 w; w.x = pk2(acc[0] - a2[0], acc[1] - a2[1]); w.y = pk2(acc[2] - a2[2], acc[3] - a2[3]); *(u32x2*)(y0u + col * 64 + row0) = w; }
                  } else if (mtx == 2) {
                      acc = tileS<false, true>(L + O_WT, L + O_BET, rt, ct, fr, fq, acc); const float dg = __expf(G63p[col]);
                      const float o0 = (row0 + 0 == col ? dg : 0.f) - acc[0], o1 = (row0 + 1 == col ? dg : 0.f) - acc[1], o2 = (row0 + 2 == col ? dg : 0.f) - acc[2], o3 = (row0 + 3 == col ? dg : 0.f) - acc[3];
                      u32x2 w; w.x = pk2(o0, o1); w.y = pk2(o2, o3); *(u32x2*)(pu + col * 64 + row0) = w;
                  } else {
                      acc = tileS<true, true>(L + O_KET, L + O_VT, rt, ct, fr, fq, acc); f32x4v a2 = {0.f, 0.f, 0.f, 0.f}; a2 = tileS<true, false>(L + O_BET, L + O_UT, rt, ct, fr, fq, a2);
                      { u32x2 w; w.x = pk2(acc[0] - a2[0], acc[1] - a2[1]); w.y = pk2(acc[2] - a2[2], acc[3] - a2[3]); *(u32x2*)(qtu + col * 64 + row0) = w; }
                  } } } }
        if (j + 1 < 16) cur = nxt;
    }
#undef RC_LOADIN
    __syncthreads();
}
__device__ __forceinline__ void phase_rc2(const Frame& F) {
    using namespace rc;
    const bf16* Pg = (const bf16*)(F.ws + WS_P); const bf16* QTg = (const bf16*)(F.ws + WS_QT); bf16* SC = (bf16*)(F.ws + WS_SC);
    const int lane = F.lane, wave = F.wave, fr = lane & 15, fq = lane >> 4;
    __syncthreads();
    if (wave == 0) {
        const int bh = F.vcu >> 2, vt = F.vcu & 3; const size_t u0 = (size_t)bh * 64;
        LAS unsigned char* Lw = F.lds;
        f32x4v S[4];
#pragma unroll
        for (int rt = 0; rt < 4; ++rt) S[rt] = (f32x4v){0.f, 0.f, 0.f, 0.f};
        const bf16* pp = Pg + u0 * 4096 + fr * 64 + 8 * fq;
        const bf16* pq = QTg + u0 * 4096 + (16 * vt + fr) * 64 + 4 * fq;
        bf16x8 pr[3][4][2]; u32x2 qr[3][4];
#define RC2_LOAD(slot, c_) do { _Pragma("unroll") for (int rt = 0; rt < 4; ++rt) { _Pragma("unroll") for (int ks = 0; ks < 2; ++ks) pr[slot][rt][ks] = *(const bf16x8*)(pp + (size_t)(c_) * 4096 + rt * 1024 + 32 * ks); \
            qr[slot][rt] = *(const u32x2*)(pq + (size_t)(c_) * 4096 + 16 * rt); } } while (0)
#define RC2_STEP(slot, c_) do { if ((c_) < 64) { bf16* sc = SC + (u0 + (c_)) * 4096 + (16 * vt + fr) * 64 + 4 * fq; \
            _Pragma("unroll") for (int rt = 0; rt < 4; ++rt) { u32x2 w; w.x = pk2(S[rt][0], S[rt][1]); w.y = pk2(S[rt][2], S[rt][3]); \
                *(u32x2*)(sc + 16 * rt) = w; *(LAS u32x2*)(Lw + (fr * PB + 16 * rt + 4 * fq) * 2) = w; } \
            asm volatile("s_waitcnt lgkmcnt(0)" ::: "memory"); \
            const bf16x8 b0 = *(const LAS bf16x8*)(Lw + (fr * PB + 8 * fq) * 2), b1 = *(const LAS bf16x8*)(Lw + (fr * PB + 32 + 8 * fq) * 2); \
            _Pragma("unroll") for (int rt = 0; rt < 4; ++rt) { f32x4v acc = {bflo(qr[slot][rt].x), bfhi(qr[slot][rt].x), bflo(qr[slot][rt].y), bfhi(qr[slot][rt].y)}; \
                acc = mma(pr[slot][rt][0], b0, acc); acc = mma(pr[slot][rt][1], b1, acc); S[rt] = acc; } \
            asm volatile("s_waitcnt lgkmcnt(0)" ::: "memory"); \
            if ((c_) + 3 < 64) RC2_LOAD(slot, (c_) + 3); } } while (0)
        RC2_LOAD(0, 0); RC2_LOAD(1, 1); RC2_LOAD(2, 2);
#pragma unroll 1
        for (int c = 0; c < 66; c += 3) { RC2_STEP(0, c); RC2_STEP(1, c + 1); RC2_STEP(2, c + 2); }
#undef RC2_LOAD
#undef RC2_STEP
    }
    __syncthreads();
}
__device__ __forceinline__ void phase_rc3(const Frame& F) {
    using namespace rc;
    const bf16* RWg = (const bf16*)(F.ws + WS_RW); const bf16* Y0g = (const bf16*)(F.ws + WS_Y0); const bf16* SC = (const bf16*)(F.ws + WS_SC); bf16* Y = (bf16*)(F.ws + WS_Y);
    const int lane = F.lane, fr = lane & 15, fq = lane >> 4;
    const int gw = F.vcu * 8 + F.wave, NGW = F.G * 8;
    for (int it = gw; it < 4096 * 4; it += NGW) {
        const int u = it >> 2, rt = it & 3, bh = u >> 6, ch = u & 63, b = bh >> 3, h = bh & 7;
        const bf16* rwu = RWg + (size_t)u * 4096; const bf16* y0u = Y0g + (size_t)u * 4096; const bf16* sc = SC + (size_t)u * 4096;
        bf16x8 a[2];
#pragma unroll
        for (int ks = 0; ks < 2; ++ks) a[ks] = *(const bf16x8*)(sc + (16 * rt + fr) * 64 + 32 * ks + 8 * fq);
#pragma unroll
        for (int ct = 0; ct < 4; ++ct) { const int tt = 16 * ct + fr, v0 = 16 * rt + 4 * fq;
            const u32x2 y0w = *(const u32x2*)(y0u + tt * 64 + v0); f32x4v acc = {bflo(y0w.x), bfhi(y0w.x), bflo(y0w.y), bfhi(y0w.y)};
#pragma unroll
            for (int ks = 0; ks < 2; ++ks) acc = mma(a[ks], *(const bf16x8*)(rwu + (16 * ct + fr) * 64 + 32 * ks + 8 * fq), acc);
            u32x2 w; w.x = pk2(acc[0], acc[1]); w.y = pk2(acc[2], acc[3]);
            *(u32x2*)(Y + ((size_t)b * SEQ + 64 * ch + tt) * 512 + h * 64 + v0) = w; }
    }
}
__device__ __forceinline__ void phase_rc23(const Frame& F) {
    using namespace rc;
    const bf16* Pg = (const bf16*)(F.ws + WS_P); const bf16* QTg = (const bf16*)(F.ws + WS_QT);
    const bf16* RWg = (const bf16*)(F.ws + WS_RW); const bf16* Y0g = (const bf16*)(F.ws + WS_Y0); bf16* Y = (bf16*)(F.ws + WS_Y);
    const int lane = F.lane, wave = F.wave, fr = lane & 15, fq = lane >> 4;
    volatile LAS unsigned* prog = (volatile LAS unsigned*)(F.lds + LDS_BYTES - 512) + 8;
    constexpr int STRIP = 16 * PB * 2;
    __syncthreads();
    if (F.tid == 0) *prog = 0u;
    __syncthreads();
    const int bh = F.vcu >> 2, vt = F.vcu & 3, b = bh >> 3, h = bh & 7; const size_t u0 = (size_t)bh * 64;
    if (wave == 0) {
        f32x4v S[4];
#pragma unroll
        for (int rt = 0; rt < 4; ++rt) S[rt] = (f32x4v){0.f, 0.f, 0.f, 0.f};
        const bf16* pp = Pg + u0 * 4096 + fr * 64 + 8 * fq;
        const bf16* pq = QTg + u0 * 4096 + (16 * vt + fr) * 64 + 4 * fq;
        bf16x8 pr[3][4][2]; u32x2 qr[3][4];
#define RC2_LOAD(slot, c_) do { _Pragma("unroll") for (int rt = 0; rt < 4; ++rt) { _Pragma("unroll") for (int ks = 0; ks < 2; ++ks) pr[slot][rt][ks] = *(const bf16x8*)(pp + (size_t)(c_) * 4096 + rt * 1024 + 32 * ks); \
            qr[slot][rt] = *(const u32x2*)(pq + (size_t)(c_) * 4096 + 16 * rt); } } while (0)
#define RC2_STEP(slot, c_) do { if ((c_) < 64) { LAS unsigned char* Lw = F.lds + (c_) * STRIP; \
            _Pragma("unroll") for (int rt = 0; rt < 4; ++rt) { u32x2 w; w.x = pk2(S[rt][0], S[rt][1]); w.y = pk2(S[rt][2], S[rt][3]); \
                *(LAS u32x2*)(Lw + (fr * PB + 16 * rt + 4 * fq) * 2) = w; } \
            asm volatile("s_waitcnt lgkmcnt(0)" ::: "memory"); \
            if (lane == 0) *prog = (unsigned)((c_) + 1);                  \
            const bf16x8 b0 = *(const LAS bf16x8*)(Lw + (fr * PB + 8 * fq) * 2), b1 = *(const LAS bf16x8*)(Lw + (fr * PB + 32 + 8 * fq) * 2); \
            _Pragma("unroll") for (int rt = 0; rt < 4; ++rt) { f32x4v acc = {bflo(qr[slot][rt].x), bfhi(qr[slot][rt].x), bflo(qr[slot][rt].y), bfhi(qr[slot][rt].y)}; \
                acc = mma(pr[slot][rt][0], b0, acc); acc = mma(pr[slot][rt][1], b1, acc); S[rt] = acc; } \
            if ((c_) + 3 < 64) RC2_LOAD(slot, (c_) + 3); } } while (0)
        RC2_LOAD(0, 0); RC2_LOAD(1, 1); RC2_LOAD(2, 2);
#pragma unroll 1
        for (int c = 0; c < 66; c += 3) { RC2_STEP(0, c); RC2_STEP(1, c + 1); RC2_STEP(2, c + 2); }
#undef RC2_LOAD
#undef RC2_STEP
    } else {
#pragma unroll 1
        for (int c = wave - 1; c < 64; c += 7) {
            const size_t u = u0 + c; const bf16* rwu = RWg + u * 4096; const bf16* y0u = Y0g + u * 4096; const int v0 = 16 * vt + 4 * fq;
            bf16x8 bq[4][2]; u32x2 y0w[4];
#pragma unroll
            for (int ct = 0; ct < 4; ++ct) { const int tt = 16 * ct + fr;
#pragma unroll
                for (int ks = 0; ks < 2; ++ks) bq[ct][ks] = *(const bf16x8*)(rwu + tt * 64 + 32 * ks + 8 * fq);
                y0w[ct] = *(const u32x2*)(y0u + tt * 64 + v0); }
            while (*prog <= (unsigned)c) __builtin_amdgcn_s_sleep(2);
            const LAS unsigned char* Lw = F.lds + c * STRIP;
            const bf16x8 a0 = *(const LAS bf16x8*)(Lw + (fr * PB + 8 * fq) * 2), a1 = *(const LAS bf16x8*)(Lw + (fr * PB + 32 + 8 * fq) * 2);
#pragma unroll
            for (int ct = 0; ct < 4; ++ct) { const int tt = 16 * ct + fr;
                f32x4v acc = {bflo(y0w[ct].x), bfhi(y0w[ct].x), bflo(y0w[ct].y), bfhi(y0w[ct].y)};
                acc = mma(a0, bq[ct][0], acc); acc = mma(a1, bq[ct][1], acc);
                u32x2 w; w.x = pk2(acc[0], acc[1]); w.y = pk2(acc[2], acc[3]);
                *(u32x2*)(Y + ((size_t)b * SEQ + 64 * c + tt) * 512 + h * 64 + v0) = w; }
        }
    }
    __syncthreads();
}
constexpr int NPHASE = 14;
constexpr int CW_BAR = 4096;
constexpr int MISC_OFF = LDS_BYTES - 256;
#define RLX_AGENT __ATOMIC_RELAXED, __HIP_MEMORY_SCOPE_AGENT
#define XB_TMO      128
#define XB_XCNT(j)  (256  + 64 * (j))
#define XB_XSUB(j)  (1280 + 64 * (j))
#define XB_XGEN(j)  (2304 + 64 * (j))
#define XB_TOP      3328
#define XB_TOPGEN   3392
#define XCD_BAR_WORDS 3456
#define XB_SPIN_CAP (1u << 18)

__device__ __forceinline__ unsigned xb_ld(unsigned* p)              { return __hip_atomic_load(p, __ATOMIC_RELAXED, __HIP_MEMORY_SCOPE_AGENT); }
__device__ __forceinline__ unsigned xb_add(unsigned* p, unsigned v) { return __hip_atomic_fetch_add(p, v, __ATOMIC_RELAXED, __HIP_MEMORY_SCOPE_AGENT); }
__device__ __forceinline__ unsigned xb_xcc_id() { return (unsigned)__builtin_amdgcn_s_getreg((3 << 11) | 20) & 0xFu; }
#define XB_SPIN(cond, bar) do { unsigned _sp = 0; while (cond) { __builtin_amdgcn_s_sleep(1); \
    if ((++_sp & 255u) == 0u) { if (xb_ld(&(bar)[XB_TMO])) break; if (_sp > XB_SPIN_CAP) { atomicAdd(&(bar)[XB_TMO], 1u); break; } } } } while (0)

struct XcdBarrier {
    unsigned* bar; unsigned x;
    volatile LAS unsigned* st;
};

__device__ __forceinline__ XcdBarrier xcd_barrier_post(unsigned* bar, volatile LAS unsigned* st) {
    XcdBarrier b; b.bar = bar; b.x = xb_xcc_id(); b.st = st;
    if (threadIdx.x == 0) (void)xb_add(&bar[XB_XCNT(b.x)], 1u);
    return b;
}
__device__ __forceinline__ void xcd_barrier_complete(unsigned* bar, unsigned x, unsigned& nloc, unsigned& nx) {
    const unsigned G = gridDim.x * gridDim.y * gridDim.z;
    unsigned sum, cnt, mine, sp = 0u;
    for (;;) {
        sum = 0u; cnt = 0u; mine = 0u;
#pragma unroll
        for (unsigned j = 0; j < 16; ++j) { const unsigned c = xb_ld(&bar[XB_XCNT(j)]); sum += c; cnt += (c > 0u) ? 1u : 0u; mine = (j == x) ? c : mine; }
        if (sum == G) break;
        __builtin_amdgcn_s_sleep(1);
        if ((++sp & 255u) == 0u) { if (xb_ld(&bar[XB_TMO])) break; if (sp > XB_SPIN_CAP) { atomicAdd(&bar[XB_TMO], 1u); break; } }
    }
    nloc = mine > 0u ? mine : 1u; nx = cnt > 0u ? cnt : 1u;
}

__device__ __forceinline__ void xcd_barrier(const XcdBarrier& b) {
    asm volatile("s_waitcnt vmcnt(0)" ::: "memory");
    __syncthreads();
    if (threadIdx.x == 0) {
        unsigned* bar = b.bar;
        __builtin_amdgcn_s_waitcnt(0);
        unsigned nloc = b.st[0], nx = b.st[1];
        if (nloc == 0u) { xcd_barrier_complete(bar, b.x, nloc, nx); b.st[0] = nloc; b.st[1] = nx; }
        const unsigned old = xb_add(&bar[XB_XSUB(b.x)], 1u);
        const unsigned gen = old / nloc;
        if (old + 1u == (gen + 1u) * nloc) {
            __builtin_amdgcn_fence(__ATOMIC_RELEASE, "agent");
            asm volatile("s_waitcnt vmcnt(0)" ::: "memory");
            const unsigned og = xb_add(&bar[XB_TOP], 1u);
            const unsigned tg = og / nx;
            if (og + 1u == (tg + 1u) * nx) xb_add(&bar[XB_TOPGEN], 1u);
            else XB_SPIN(xb_ld(&bar[XB_TOPGEN]) == tg, bar);
            __builtin_amdgcn_fence(__ATOMIC_ACQUIRE, "agent");
            xb_add(&bar[XB_XGEN(b.x)], 1u);
            asm volatile("s_waitcnt vmcnt(0)" ::: "memory");
        } else {
            XB_SPIN(xb_ld(&bar[XB_XGEN(b.x)]) == gen, bar);
            __builtin_amdgcn_fence(__ATOMIC_ACQUIRE, "agent");
            asm volatile("s_waitcnt vmcnt(0)" ::: "memory");
        }
    }
    __syncthreads();
}

template <class Epi> __device__ __forceinline__ void run_gemm(const Frame& F, const bf16* A, const bf16* Bt, int N, int K, const Epi& E) {
    pg8::Gemm g{A, Bt, T, N, K}; pg8::StaticOrder S; S.init(T, N, F.G, (int)blockIdx.x);
    pg8::gemm_phase<Epi, pg8::StaticOrder, true, true>(F.lds, g, S, E);
}
__global__ void __launch_bounds__(512, 2) mega(Args args) {
    extern __shared__ __attribute__((aligned(16))) unsigned char lds_raw[];
    Frame F;
    F.lds = (LAS unsigned char*)lds_raw; F.tid = threadIdx.x; F.lane = F.tid & 63; F.wave = __builtin_amdgcn_readfirstlane(F.tid >> 6);
    F.G = gridDim.x; { const int bx = blockIdx.x; F.vcu = (F.G % 8 == 0) ? (bx % 8) * (F.G / 8) + bx / 8 : bx; }
#pragma unroll
    for (int i = 0; i < 23; ++i) F.in[i] = args.in[i];
    F.out = args.out; F.ws = args.ws;
    unsigned char* ws = args.ws;
    const int lo = args.ph_lo, hi = args.ph_hi;
    for (int u = F.tid; u < 512 / 4; u += 512) ((LAS unsigned*)(F.lds + LDS_BYTES - 512))[u] = 0u;
    __syncthreads();
    XcdBarrier bar = xcd_barrier_post((unsigned*)(ws + WS_CTL) + CW_BAR, (volatile LAS unsigned*)(F.lds + MISC_OFF) + 8);
#define IN(k) (lo <= (k) && (k) < hi)
#define SEAM(k) do { if (IN(k) && IN((k) + 1)) xcd_barrier(bar); } while (0)
    if (IN(0)) phase_p0(F);
    SEAM(0);
    if (IN(1)) { EpiInProj E{(bf16*)(ws + WS_Q), (bf16*)(ws + WS_K), (bf16*)(ws + WS_V), (bf16*)(ws + WS_QI), (bf16*)(ws + WS_KI), (bf16*)(ws + WS_Z), (bf16*)F.out, (float*)(ws + WS_WI), F.in[3], F.in[4]};
        run_gemm(F, (const bf16*)(ws + WS_XN), (const bf16*)(ws + WS_WIN), NPROJ, 1024, E); }
    SEAM(1);
    if (IN(2)) phase_idx(F);
    if (IN(3)) phase_pr1(F);
    SEAM(3);
    if (IN(4)) { const bf16* A12 = (const bf16*)(ws + WS_A12); const bf16* WL = (const bf16*)(ws + WS_WL);
        { EpiLoraAll E{(float*)(ws + WS_XN), (bf16*)(ws + WS_AA), (bf16*)(ws + WS_GG), F.in[7], F.in[9]}; run_gemm(F, A12, WL, 1536, LK, E); } }
    if (IN(6)) phase_attn(F);
    SEAM(6);
    if (IN(7)) { phase_rc1(F); xcd_barrier(bar); phase_rc23(F); }
    SEAM(7);
    if (IN(8)) phase_post(F);
    SEAM(8);
    if (IN(9)) { EpiBranchFused E{(const bf16*)F.out, (bf16*)(ws + WS_MRG)}; run_gemm(F, (const bf16*)(ws + WS_YA2), (const bf16*)(ws + WS_WBA), 1024, 1024, E); }
    SEAM(10);
    if (IN(11)) { EpiOut E{F.in[0], F.out, (bf16*)(ws + WS_XN), (float*)(ws + WS_SSQ)}; run_gemm(F, (const bf16*)(ws + WS_MRG), (const bf16*)(ws + WS_WO), 1024, 1024, E); }
    SEAM(11);
    if (IN(12)) { EpiGateUp E{(const float*)(ws + WS_SSQ), (bf16*)(ws + WS_ACT)}; run_gemm(F, (const bf16*)(ws + WS_XN), (const bf16*)(ws + WS_WGU), 2 * FFH, 1024, E); }
    SEAM(12);
    if (IN(13)) { EpiDown E{F.out, (const bf16*)(ws + WS_XN)}; run_gemm(F, (const bf16*)(ws + WS_ACT), (const bf16*)(ws + WS_WD), 1024, FFH, E); }
#undef IN
}

extern "C" void kernel_launch(void* const* d_in, const int* in_sizes, int n_in, void* d_out, int out_size, void* d_ws, size_t ws_size, hipStream_t stream) {
    static int grid = 0;
    if (grid == 0) {
        if (n_in != 23 || in_sizes[0] != T * DM || out_size != T * DM || ws_size < WS_END) { fprintf(stderr, "kernel_launch: unexpected shapes (n_in %d, x %d, out %d, ws %zu)\n", n_in, n_in > 0 ? in_sizes[0] : -1, out_size, ws_size); grid = -1; return; }
        if (hipFuncSetAttribute((const void*)mega, hipFuncAttributeMaxDynamicSharedMemorySize, LDS_BYTES) != hipSuccess) { fprintf(stderr, "kernel_launch: hipFuncSetAttribute failed\n"); grid = -1; return; }
        grid = 256;
    }
    if (grid < 0) return;
    Args a{};
    for (int i = 0; i < 23; ++i) a.in[i] = (const float*)d_in[i];
    a.out = (float*)d_out; a.ws = (unsigned char*)d_ws;
    if (hipMemsetAsync((char*)d_ws + WS_CTL, 0, 32 * 1024  , stream) != hipSuccess) { fprintf(stderr, "kernel_launch: memset failed\n"); return; }
    a.ph_lo = 0; a.ph_hi = NPHASE;
    hipLaunchKernelGGL(mega, dim3(grid), dim3(512), LDS_BYTES, stream, a);
}
```

```cpp
#include <hip/hip_runtime.h>
#include <cstdio>
#include <cstdint>
namespace pg8 {
#define PG8_LAS __attribute__((address_space(3)))
typedef unsigned short bf16_t;
typedef short bf16x8 __attribute__((ext_vector_type(8)));
typedef float f32x4 __attribute__((ext_vector_type(4)));
typedef unsigned u32x4 __attribute__((ext_vector_type(4)));
constexpr int BM = 256, BK = 64, HALF = 128, HTB = HALF * BK * 2  , STAGE_BYTES = 8 * HTB, NXCD = 8, WGM = 8;

__host__ __device__ __forceinline__ int lds_byte(int r, int c) { const int st = (r >> 4) * 2 + (c >> 5), rr = r & 15, cc = c & 31, ob = rr * 64 + cc * 2; return st * 1024 + (ob ^ (((ob >> 9) & 1) << 5)); }
__host__ __device__ __forceinline__ void stage_rc(int b, int& R, int& C) { const int st = b / 1024, sb = b % 1024, swz = sb ^ (((sb >> 9) & 1) << 5); R = (st >> 1) * 16 + swz / 64; C = (st & 1) * 32 + (swz % 64) / 2; }
__host__ __device__ __forceinline__ int perm32(int rho) { const int n = rho >> 4, i = rho & 15; return 8 * (i >> 2) + 4 * n + (i & 3); }

struct Unit { int pm, pn; };
struct Gemm { const bf16_t* A; const bf16_t* Bt; int M, N, K; };

struct StaticOrder {
    int nM, nN, nwg, G, c;
    __host__ __device__ void init(int M, int N, int G_, int c_) { nM = M / BM; nN = N / BM; nwg = nM * nN; G = G_; c = c_; }
    __host__ __device__ bool next(int i, Unit& u) const {
        const long L = (long)i * G + c; if (L >= nwg) return false;
        int wgid = (int)L; { const int q = nwg / NXCD, r = nwg % NXCD, xcd = wgid % NXCD, off = wgid / NXCD; wgid = (xcd < r ? xcd * (q + 1) : r * (q + 1) + (xcd - r) * q) + off; }
        const int nig = WGM * nN, gid = wgid / nig, fm = gid * WGM, gsz = (nM - fm) < WGM ? (nM - fm) : WGM;
        u.pm = fm + ((wgid % nig) % gsz); u.pn = (wgid % nig) / gsz; return true;
    }
    __device__ __forceinline__ void a_ready(const Unit&) const {}
    __device__ __forceinline__ void done(const Unit&) const {}
};
__device__ __forceinline__ unsigned cvt_pk_bf16(float lo, float hi) { unsigned r; asm volatile("v_cvt_pk_bf16_f32 %0, %1, %2" : "=v"(r) : "v"(lo), "v"(hi)); return r; }
typedef float f32x2 __attribute__((ext_vector_type(2)));
template <class Epi, class Sched, bool ALIGN_EPI = false, bool SP2 = false>
__device__ __forceinline__ void gemm_phase(PG8_LAS unsigned char* lds, const Gemm g, const Sched& S, const Epi& E) {
    const int tid = threadIdx.x, wid = __builtin_amdgcn_readfirstlane(tid >> 6), lane = tid & 63, wr = wid >> 2, wc = wid & 3, fr = lane & 15, fq = lane >> 4;
    const int K = g.K, nt = K / BK;
    unsigned voffA[2], voffB[2];
#pragma unroll
    for (int i = 0; i < 2; ++i) { int R, C; stage_rc(tid * 16 + i * 8192, R, C); const int Rb = Epi::PERM ? ((R & ~31) + perm32(R & 31)) : R;
        voffA[i] = (unsigned)(R * K + C) * 2u; voffB[i] = (unsigned)(Rb * K + C) * 2u; }
    const size_t kstep = (size_t)(BK * 2);
    const size_t hstep = (size_t)HALF * K * 2;
    const size_t tstep = 2 * hstep;
    const unsigned ldsw = (unsigned)wid * 1024u;
    const int aoff = lds_byte(wr * 64 + fr, fq * 8), boff = lds_byte(wc * 32 + fr, fq * 8);
#define PG8_SA(b, h) (((b) * 2 + (h)) * HTB)
#define PG8_SB(b, h) ((4 + (b) * 2 + (h)) * HTB)
#define PG8_STAGE(bufoff, gbase, voff) do { _Pragma("unroll") for (int _i = 0; _i < 2; ++_i) \
        __builtin_amdgcn_global_load_lds((const unsigned*)((const char*)(gbase) + (voff)[_i]), (PG8_LAS unsigned*)(lds + (bufoff) + ldsw + _i * 8192), 16, 0, 0); } while (0)
#define PG8_LDA(dst, b, h) do { _Pragma("unroll") for (int m = 0; m < 4; ++m) _Pragma("unroll") for (int k = 0; k < 2; ++k) dst[m][k] = *(const PG8_LAS bf16x8*)(lds + PG8_SA(b, h) + aoff + m * 2048 + k * 1024); } while (0)
#define PG8_LDB(dst, b, h) do { _Pragma("unroll") for (int n = 0; n < 2; ++n) _Pragma("unroll") for (int k = 0; k < 2; ++k) dst[n][k] = *(const PG8_LAS bf16x8*)(lds + PG8_SB(b, h) + boff + n * 2048 + k * 1024); } while (0)
#define PG8_MMA(ai, bj, At, Bt) do { __builtin_amdgcn_s_setprio(1); _Pragma("unroll") for (int m = 0; m < 4; ++m) _Pragma("unroll") for (int n = 0; n < 2; ++n) _Pragma("unroll") for (int k = 0; k < 2; ++k) \
        acc[ai][bj][m][n] = __builtin_amdgcn_mfma_f32_16x16x32_bf16(Bt[n][k], At[m][k], acc[ai][bj][m][n], 0, 0, 0); __builtin_amdgcn_s_setprio(0); } while (0)
#define PG8_WAIT_V(n) asm volatile("s_waitcnt vmcnt(" #n ")" ::: "memory")
#define PG8_WAIT_L(n) asm volatile("s_waitcnt lgkmcnt(" #n ")" ::: "memory")
#define PG8_BAR __builtin_amdgcn_s_barrier()
#define PG8_SCHED __builtin_amdgcn_sched_barrier(0)
    Unit cur, nxt; int ui = 0;
    if (!S.next(0, cur)) return;
    f32x4 acc[2][2][4][2];
#pragma unroll
    for (int a = 0; a < 2; ++a)
#pragma unroll
        for (int b = 0; b < 2; ++b)
#pragma unroll
            for (int m = 0; m < 4; ++m)
#pragma unroll
                for (int n = 0; n < 2; ++n) acc[a][b][m][n] = (f32x4){0.f, 0.f, 0.f, 0.f};
    bf16x8 At[4][2], B0[2][2], B1[2][2];
    const char* cA = (const char*)g.A + (size_t)cur.pm * tstep; const char* cB = (const char*)g.Bt + (size_t)cur.pn * tstep;
    S.a_ready(cur);
    if constexpr (SP2) {
        PG8_STAGE(PG8_SB(0, 0), cB, voffB); PG8_STAGE(PG8_SB(0, 1), cB + hstep, voffB); PG8_STAGE(PG8_SA(0, 0), cA, voffA); PG8_STAGE(PG8_SA(0, 1), cA + hstep, voffA);
        if (wr == 1) PG8_BAR;
        PG8_WAIT_V(2); PG8_BAR;
        PG8_STAGE(PG8_SB(1, 0), cB + kstep, voffB); PG8_STAGE(PG8_SA(1, 0), cA + kstep, voffA); PG8_STAGE(PG8_SB(1, 1), cB + hstep + kstep, voffB);
        PG8_WAIT_V(6); PG8_BAR;
    } else {
        PG8_STAGE(PG8_SB(0, 0), cB, voffB); PG8_STAGE(PG8_SA(0, 0), cA, voffA); PG8_STAGE(PG8_SB(0, 1), cB + hstep, voffB); PG8_STAGE(PG8_SA(0, 1), cA + hstep, voffA);
        if (wr == 1) PG8_BAR;
        PG8_WAIT_V(4); PG8_BAR;
        PG8_STAGE(PG8_SB(1, 0), cB + kstep, voffB); PG8_STAGE(PG8_SA(1, 0), cA + kstep, voffA); PG8_STAGE(PG8_SB(1, 1), cB + hstep + kstep, voffB);
        PG8_WAIT_V(6); PG8_BAR;
    }
    for (;;) {
        const bool has_next = S.next(ui + 1, nxt);
        const char* nA = has_next ? (const char*)g.A + (size_t)nxt.pm * tstep : cA; const char* nB = has_next ? (const char*)g.Bt + (size_t)nxt.pn * tstep : cB;
        _Pragma("unroll 1") for (int t = 0; t < nt; t += 2) {
            if constexpr (Epi::MID_T > 0) { if (t == Epi::MID_T) E.mid(acc, cur, wr, wc, fr, fq); }
            const bool last = (t == nt - 2);
            const char* a1 = cA + (size_t)(t + 1) * kstep;
            const char* a2 = last ? nA : cA + (size_t)(t + 2) * kstep; const char* b2 = last ? nB : cB + (size_t)(t + 2) * kstep;
            const char* a3 = a2 + kstep; const char* b3 = b2 + kstep;
            if (last && has_next) S.a_ready(nxt);
            if constexpr (SP2) {
            PG8_LDB(B0, 0, 0); PG8_LDB(B1, 0, 1); PG8_SCHED; PG8_LDA(At, 0, 0); PG8_STAGE(PG8_SA(1, 1), a1 + hstep, voffA);
            PG8_WAIT_V(8); PG8_WAIT_L(0); PG8_BAR; PG8_MMA(0, 0, At, B0); PG8_MMA(0, 1, At, B1); PG8_BAR; PG8_SCHED;
            PG8_LDA(At, 0, 1); PG8_STAGE(PG8_SB(0, 0), b2, voffB); PG8_STAGE(PG8_SB(0, 1), b2 + hstep, voffB); PG8_STAGE(PG8_SA(0, 0), a2, voffA);
            PG8_WAIT_V(8); PG8_WAIT_L(0); PG8_BAR; PG8_MMA(1, 0, At, B0); PG8_MMA(1, 1, At, B1); PG8_BAR; PG8_SCHED;
            PG8_LDB(B0, 1, 0); PG8_LDB(B1, 1, 1); PG8_SCHED; PG8_LDA(At, 1, 0); PG8_STAGE(PG8_SA(0, 1), a2 + hstep, voffA);
            PG8_WAIT_V(8); PG8_WAIT_L(0); PG8_BAR; PG8_MMA(0, 0, At, B0); PG8_MMA(0, 1, At, B1); PG8_BAR; PG8_SCHED;
            PG8_LDA(At, 1, 1); PG8_STAGE(PG8_SB(1, 0), b3, voffB); PG8_STAGE(PG8_SB(1, 1), b3 + hstep, voffB); PG8_STAGE(PG8_SA(1, 0), a3, voffA);
            PG8_WAIT_V(8); PG8_WAIT_L(0); PG8_BAR; PG8_MMA(1, 0, At, B0); PG8_MMA(1, 1, At, B1); PG8_BAR; PG8_SCHED;
            } else {
            PG8_LDB(B0, 0, 0); PG8_SCHED; PG8_LDA(At, 0, 0); PG8_STAGE(PG8_SA(1, 1), a1 + hstep, voffA);
            PG8_WAIT_L(8); PG8_BAR; PG8_WAIT_L(0); PG8_MMA(0, 0, At, B0); PG8_BAR; PG8_SCHED;
            PG8_LDB(B1, 0, 1); PG8_STAGE(PG8_SB(0, 0), b2, voffB);
            PG8_BAR; PG8_WAIT_L(0); PG8_MMA(0, 1, At, B1); PG8_BAR;
            PG8_LDA(At, 0, 1); PG8_STAGE(PG8_SA(0, 0), a2, voffA);
            PG8_BAR; PG8_WAIT_L(0); PG8_MMA(1, 0, At, B0); PG8_BAR; PG8_SCHED;
            PG8_STAGE(PG8_SB(0, 1), b2 + hstep, voffB);
            PG8_WAIT_V(6); PG8_BAR; PG8_MMA(1, 1, At, B1); PG8_BAR;
            PG8_LDB(B0, 1, 0); PG8_SCHED; PG8_LDA(At, 1, 0); PG8_STAGE(PG8_SA(0, 1), a2 + hstep, voffA);
            PG8_WAIT_L(8); PG8_BAR; PG8_WAIT_L(0); PG8_MMA(0, 0, At, B0); PG8_BAR; PG8_SCHED;
            PG8_LDB(B1, 1, 1); PG8_STAGE(PG8_SB(1, 0), b3, voffB);
            PG8_BAR; PG8_WAIT_L(0); PG8_MMA(0, 1, At, B1); PG8_BAR;
            PG8_LDA(At, 1, 1); PG8_STAGE(PG8_SA(1, 0), a3, voffA);
            PG8_BAR; PG8_WAIT_L(0); PG8_MMA(1, 0, At, B0); PG8_BAR; PG8_SCHED;
            PG8_STAGE(PG8_SB(1, 1), b3 + hstep, voffB);
            PG8_WAIT_V(6); PG8_BAR; PG8_MMA(1, 1, At, B1); PG8_BAR;
            }
        }
        if constexpr (ALIGN_EPI) { if (wr == 0) PG8_BAR; }
        if constexpr (!Epi::AFTER_DRAIN) { E(acc, cur, wr, wc, fr, fq); S.done(cur); }
        if (!has_next) break;
#pragma unroll
        for (int a = 0; a < 2; ++a)
#pragma unroll
            for (int b = 0; b < 2; ++b)
#pragma unroll
                for (int m = 0; m < 4; ++m)
#pragma unroll
                    for (int n = 0; n < 2; ++n) acc[a][b][m][n] = (f32x4){0.f, 0.f, 0.f, 0.f};
        cur = nxt; cA = nA; cB = nB; ++ui;
        if constexpr (ALIGN_EPI) { if (wr == 1) PG8_BAR; }
    }
    PG8_WAIT_V(0);
    if constexpr (!ALIGN_EPI) { if (wr == 0) PG8_BAR; }
    PG8_BAR;
    if constexpr (Epi::AFTER_DRAIN) { E.fused(acc, cur, wr, wc, fr, fq, lds, wid, lane); S.done(cur); }
#undef PG8_SA
#undef PG8_SB
#undef PG8_STAGE
#undef PG8_LDA
#undef PG8_LDB
#undef PG8_MMA
#undef PG8_WAIT_V
#undef PG8_WAIT_L
#undef PG8_BAR
#undef PG8_SCHED
}
}
#define LAS __attribute__((address_space(3)))
typedef unsigned short bf16;
typedef short bf16x8 __attribute__((ext_vector_type(8)));
typedef float f32x4 __attribute__((ext_vector_type(4)));
typedef float f32x16 __attribute__((ext_vector_type(16)));
typedef unsigned u32x4 __attribute__((ext_vector_type(4)));
typedef unsigned u32x2 __attribute__((ext_vector_type(2)));
typedef short s16x4 __attribute__((ext_vector_type(4)));

constexpr int NB = 8, SEQ = 4096, T = NB * SEQ, DM = 1024;
constexpr int IN_W = 5992, NPROJ = 6144, RWW = 1824, FFH = 2816, LK = 384, LN_ = 1536;
constexpr float C2 = 0.125f * 1.4426950408889634f;
constexpr float LOG2E = 1.4426950408889634f;
constexpr size_t MiB = 1u << 20;
constexpr size_t WS_CTL = 0;
constexpr size_t WS_WIN = 1 * MiB, WS_WGU = 13 * MiB, WS_WD = 24 * MiB, WS_WO = 30 * MiB, WS_WBA = 32 * MiB, WS_WBR = 33 * MiB, WS_WL = 34 * MiB;
constexpr size_t WS_Q = 36 * MiB, WS_K = 68 * MiB, WS_V = 100 * MiB;
constexpr size_t WS_QI = 132 * MiB;
constexpr size_t WS_AA = 132 * MiB;
constexpr size_t WS_YA2 = 379 * MiB;
constexpr size_t WS_KI = 164 * MiB, WS_WI = 168 * MiB;
constexpr size_t WS_XN = 169 * MiB;
constexpr size_t WS_Z = 233 * MiB;
constexpr size_t WS_GG = 347 * MiB, WS_BV = 132 * MiB  , WS_KK = 265 * MiB, WS_BB = 297 * MiB;
constexpr size_t WS_MRG = 36 * MiB;
constexpr size_t WS_SSQ = 329 * MiB;
constexpr size_t WS_ACT = 331 * MiB;
constexpr size_t WS_SCR = 347 * MiB;
constexpr size_t WS_RKV = 347 * MiB;
constexpr size_t WS_A12 = 443 * MiB;
constexpr size_t WS_Y = 443 * MiB;
constexpr size_t WS_MASK = 475 * MiB;
constexpr size_t WS_RW = 36 * MiB, WS_Y0 = 68 * MiB, WS_P = 100 * MiB;
constexpr size_t WS_QT = 475 * MiB;
constexpr size_t WS_SC = 169 * MiB;
constexpr size_t WS_END = 507 * MiB;

constexpr int LDS_BYTES = 155648;

__device__ __forceinline__ unsigned f2bf(float f) { const __bf16 b = (__bf16)f; return (unsigned)__builtin_bit_cast(unsigned short, b); }
typedef float pk_f32x2_t __attribute__((ext_vector_type(2))); typedef __bf16 pk_bf16x2_t __attribute__((ext_vector_type(2)));
__device__ __forceinline__ unsigned pk2(float lo, float hi) { pk_f32x2_t v = {lo, hi}; pk_bf16x2_t b = __builtin_convertvector(v, pk_bf16x2_t); return __builtin_bit_cast(unsigned, b); }
__device__ __forceinline__ float bflo(unsigned w) { return __builtin_bit_cast(float, w << 16); }
__device__ __forceinline__ float bfhi(unsigned w) { return __builtin_bit_cast(float, w & 0xffff0000u); }
__device__ __forceinline__ float sigmoidf_(float x) { return __builtin_amdgcn_rcpf(1.0f + __expf(-x)); }
__device__ __forceinline__ void unpack8(const u32x4 w, float (&f)[8]) { f[0] = bflo(w.x); f[1] = bfhi(w.x); f[2] = bflo(w.y); f[3] = bfhi(w.y); f[4] = bflo(w.z); f[5] = bfhi(w.z); f[6] = bflo(w.w); f[7] = bfhi(w.w); }
__device__ __forceinline__ u32x4 pack8(const float (&f)[8]) { u32x4 w; w.x = pk2(f[0], f[1]); w.y = pk2(f[2], f[3]); w.z = pk2(f[4], f[5]); w.w = pk2(f[6], f[7]); return w; }

struct Args { const float* in[23]; float* out; unsigned char* ws; int ph_lo, ph_hi; };

struct Frame {
    LAS unsigned char* lds; int tid, lane, wave, vcu, G;
    const float* in[23]; float* out; unsigned char* ws;
};
#define EPI_ARGS const pg8::f32x4 (&acc)[2][2][4][2], const pg8::Unit& u, int wr, int wc, int fr, int fq
__device__ __forceinline__ void acc8(const pg8::f32x4 (&acc)[2][2][4][2], int ai, int bj, int m, float (&v)[8]) {
    const pg8::f32x4 a = acc[ai][bj][m][0], b = acc[ai][bj][m][1];
    v[0] = a[0]; v[1] = a[1]; v[2] = a[2]; v[3] = a[3]; v[4] = b[0]; v[5] = b[1]; v[6] = b[2]; v[7] = b[3];
}
__device__ __forceinline__ void ld8f(const float* p, float (&v)[8]) { const f32x4 a = *(const f32x4*)p, b = *(const f32x4*)(p + 4); v[0] = a[0]; v[1] = a[1]; v[2] = a[2]; v[3] = a[3]; v[4] = b[0]; v[5] = b[1]; v[6] = b[2]; v[7] = b[3]; }
__device__ __forceinline__ void st8f(float* p, const float (&v)[8]) { *(f32x4*)p = (f32x4){v[0], v[1], v[2], v[3]}; *(f32x4*)(p + 4) = (f32x4){v[4], v[5], v[6], v[7]}; }

__device__ __forceinline__ float xsum_fq(float s) {
    { unsigned a = __builtin_bit_cast(unsigned, s), b = a; asm volatile("" : "+v"(b)); const auto r = __builtin_amdgcn_permlane16_swap(a, b, false, false); const unsigned r0 = r[0], r1 = r[1]; s = __builtin_bit_cast(float, r0) + __builtin_bit_cast(float, r1); }
    { unsigned a = __builtin_bit_cast(unsigned, s), b = a; asm volatile("" : "+v"(b)); const auto r = __builtin_amdgcn_permlane32_swap(a, b, false, false); const unsigned r0 = r[0], r1 = r[1]; s = __builtin_bit_cast(float, r0) + __builtin_bit_cast(float, r1); }
    return s;
}
struct EpiInProj {
    static constexpr bool PERM = true, AFTER_DRAIN = false; static constexpr int MID_T = 0;
    bf16 *Q, *K, *V, *QI, *KI, *Z, *G; float* WI; const float *qg, *kg;
    __device__ __forceinline__ void operator()(EPI_ARGS) const {
        const int pn = u.pn, row0 = u.pm * 256 + wr * 64 + fr;
        if (pn < 4) {
            const bool isq = pn < 2; const int head = 4 * (pn & 1) + wc;
            const float* gp = isq ? qg : kg; bf16* dst = isq ? Q : K; const float osc = isq ? C2 : 1.0f;
            float g0[8], g1[8]; ld8f(gp + 8 * fq, g0); ld8f(gp + 32 + 8 * fq, g1);
#pragma unroll
            for (int ai = 0; ai < 2; ++ai)
#pragma unroll
                for (int m = 0; m < 4; ++m) {
                    float a0[8], a1[8]; acc8(acc, ai, 0, m, a0); acc8(acc, ai, 1, m, a1);
                    float ss = 0.f;
#pragma unroll
                    for (int i = 0; i < 8; ++i) ss += a0[i] * a0[i] + a1[i] * a1[i];
                    ss = xsum_fq(ss);
                    const float rs = rsqrtf(ss * (1.0f / 64.0f) + 1e-6f) * osc;
#pragma unroll
                    for (int i = 0; i < 8; ++i) { a0[i] *= rs * g0[i]; a1[i] *= rs * g1[i]; }
                    bf16* rp = dst + (size_t)(row0 + ai * 128 + m * 16) * 512 + head * 64 + 8 * fq;
                    *(u32x4*)rp = pack8(a0); *(u32x4*)(rp + 32) = pack8(a1);
                }
        } else if (pn < 8) {
            bf16* dst = pn < 6 ? V : QI; const int c0 = (pn & 1) * 256 + wc * 32 + 8 * fq;
#pragma unroll
            for (int ai = 0; ai < 2; ++ai)
#pragma unroll
                for (int m = 0; m < 4; ++m)
#pragma unroll
                    for (int bj = 0; bj < 2; ++bj) { float a[8]; acc8(acc, ai, bj, m, a); *(u32x4*)(dst + (size_t)(row0 + ai * 128 + m * 16) * 512 + c0 + bj * 128) = pack8(a); }
        } else if (pn < 16) {
#pragma unroll
            for (int bj = 0; bj < 2; ++bj) {
                const int cr = (pn - 8) * 256 + bj * 128 + wc * 32 + 8 * fq;
#pragma unroll
                for (int ai = 0; ai < 2; ++ai)
#pragma unroll
                    for (int m = 0; m < 4; ++m) {
                        float a[8]; acc8(acc, ai, bj, m, a); const size_t row = (size_t)(row0 + ai * 128 + m * 16);
                        if (cr < RWW) *(u32x4*)(Z + row * RWW + cr) = pack8(a);
                        else if (cr < RWW + 64) *(u32x4*)(KI + row * 64 + (cr - RWW)) = pack8(a);
                        else if (cr == RWW + 64) st8f(WI + row * 8, a);
                    }
            }
        } else {
            const int c0 = (pn - 16) * 128 + wc * 32 + 8 * fq;
#pragma unroll
            for (int ai = 0; ai < 2; ++ai)
#pragma unroll
                for (int m = 0; m < 4; ++m) { float ga[8], gr[8]; acc8(acc, ai, 0, m, ga); acc8(acc, ai, 1, m, gr);
#pragma unroll
                    for (int i = 0; i < 8; ++i) { const float sr_ = sigmoidf_(gr[i]); ga[i] = sigmoidf_(ga[i]) * __builtin_amdgcn_rcpf(sr_); gr[i] = sr_; }
                    bf16* gp = G + (size_t)(row0 + ai * 128 + m * 16) * 2048 + c0;
                    *(u32x4*)gp = pack8(ga); *(u32x4*)(gp + 1024) = pack8(gr); }
        }
    }
};
template <int MODE> struct EpiLora {
    static constexpr bool PERM = true, AFTER_DRAIN = false; static constexpr int MID_T = 0;
    float* DEC; bf16* O; const float* bias;
    __device__ __forceinline__ void operator()(EPI_ARGS) const {
        const int row0 = u.pm * 256 + wr * 64 + fr, c0 = u.pn * 256 + wc * 32 + 8 * fq;
#pragma unroll
        for (int bj = 0; bj < 2; ++bj) { const int c = c0 + bj * 128; float bv[8];
            if (MODE < 2) ld8f(bias + c, bv);
#pragma unroll
            for (int ai = 0; ai < 2; ++ai)
#pragma unroll
                for (int m = 0; m < 4; ++m) { float a[8]; acc8(acc, ai, bj, m, a); const size_t row = (size_t)(row0 + ai * 128 + m * 16);
                    if (MODE == 0) {
#pragma unroll
                        for (int i = 0; i < 8; ++i) a[i] = -0.6065306597126334f * sigmoidf_(a[i] + bv[i]);
                        st8f(DEC + row * 512 + c, a);
                    } else if (MODE == 1) {
#pragma unroll
                        for (int i = 0; i < 8; ++i) a[i] = sigmoidf_(a[i] + bv[i]);
                        *(u32x4*)(O + row * 512 + c) = pack8(a);
                    } else *(u32x4*)(O + row * 512 + c) = pack8(a);
                } }
    }
};
struct EpiLoraAll {
    static constexpr bool PERM = true, AFTER_DRAIN = false; static constexpr int MID_T = 0;
    float* DEC; bf16* AAo; bf16* GGo; const float* bias0; const float* bias1;
    __device__ __forceinline__ void operator()(EPI_ARGS) const {
        pg8::Unit v = u; v.pn = u.pn & 1; const int mode = u.pn >> 1;
        if (mode == 0) { EpiLora<0> E{DEC, nullptr, bias0}; E(acc, v, wr, wc, fr, fq); }
        else if (mode == 1) { EpiLora<1> E{nullptr, AAo, bias1}; E(acc, v, wr, wc, fr, fq); }
        else { EpiLora<2> E{nullptr, GGo, nullptr}; E(acc, v, wr, wc, fr, fq); }
    }
};
struct EpiBranchFused {
    static constexpr bool PERM = true, AFTER_DRAIN = false; static constexpr int MID_T = 8;
    const bf16* G; bf16* MRG;
    __device__ __forceinline__ void mid(pg8::f32x4 (&acc)[2][2][4][2], const pg8::Unit& u, int wr, int wc, int fr, int fq) const {
        const bf16* gb = G + (size_t)(u.pm * 256 + wr * 64 + fr) * 2048 + u.pn * 256 + wc * 32 + 8 * fq;
        asm volatile("" : "+v"(gb));
#pragma unroll
        for (int ai = 0; ai < 2; ++ai) { u32x4 gw[4][2];
#pragma unroll
            for (int m = 0; m < 4; ++m)
#pragma unroll
                for (int bj = 0; bj < 2; ++bj) gw[m][bj] = *(const u32x4*)(gb + (size_t)(ai * 128 + m * 16) * 2048 + bj * 128);
#pragma unroll
            for (int m = 0; m < 4; ++m)
#pragma unroll
                for (int bj = 0; bj < 2; ++bj) { float g[8]; unpack8(gw[m][bj], g);
                    acc[ai][bj][m][0] = acc[ai][bj][m][0] * (pg8::f32x4){g[0], g[1], g[2], g[3]}; acc[ai][bj][m][1] = acc[ai][bj][m][1] * (pg8::f32x4){g[4], g[5], g[6], g[7]}; }
            asm volatile("" ::: "memory"); }
    }
    __device__ __forceinline__ void operator()(EPI_ARGS) const {
        const int row0 = u.pm * 256 + wr * 64 + fr, c0 = u.pn * 256 + wc * 32 + 8 * fq;
#pragma unroll
        for (int ai = 0; ai < 2; ++ai) { u32x4 gw[4][2];
#pragma unroll
            for (int m = 0; m < 4; ++m)
#pragma unroll
                for (int bj = 0; bj < 2; ++bj) gw[m][bj] = *(const u32x4*)(G + (size_t)(row0 + ai * 128 + m * 16) * 2048 + 1024 + c0 + bj * 128);
            asm volatile("" ::: "memory");
#pragma unroll
            for (int m = 0; m < 4; ++m)
#pragma unroll
                for (int bj = 0; bj < 2; ++bj) {
                    float a[8], g[8]; acc8(acc, ai, bj, m, a); const size_t row = (size_t)(row0 + ai * 128 + m * 16); const int c = c0 + bj * 128;
                    unpack8(gw[m][bj], g);
#pragma unroll
                    for (int i = 0; i < 8; ++i) a[i] = g[i] * a[i];
                    *(u32x4*)(MRG + row * 1024 + c) = pack8(a);
                }
            asm volatile("" ::: "memory"); }
    }
};
struct EpiOut {
    static constexpr bool PERM = true, AFTER_DRAIN = false; static constexpr int MID_T = 0;
    const float* x; float* out; bf16* H1B; float* SSQ;
    __device__ __forceinline__ void operator()(EPI_ARGS) const {
        const int row0 = u.pm * 256 + wr * 64 + fr, c0 = u.pn * 256 + wc * 32 + 8 * fq;
#pragma unroll
        for (int ai = 0; ai < 2; ++ai)
#pragma unroll
          for (int mp = 0; mp < 4; mp += 2) { f32x4 xw[2][2][2];
#pragma unroll
            for (int mi = 0; mi < 2; ++mi)
#pragma unroll
                for (int bj = 0; bj < 2; ++bj) { const float* xp = x + (size_t)(row0 + ai * 128 + (mp + mi) * 16) * 1024 + c0 + bj * 128; xw[mi][bj][0] = *(const f32x4*)xp; xw[mi][bj][1] = *(const f32x4*)(xp + 4); }
            asm volatile("" ::: "memory");
#pragma unroll
            for (int mi = 0; mi < 2; ++mi) { const int m = mp + mi;
                const size_t row = (size_t)(row0 + ai * 128 + m * 16); float ss = 0.f;
#pragma unroll
                for (int bj = 0; bj < 2; ++bj) {
                    float a[8]; acc8(acc, ai, bj, m, a); const int c = c0 + bj * 128;
                    const float xv[8] = {xw[mi][bj][0][0], xw[mi][bj][0][1], xw[mi][bj][0][2], xw[mi][bj][0][3], xw[mi][bj][1][0], xw[mi][bj][1][1], xw[mi][bj][1][2], xw[mi][bj][1][3]};
#pragma unroll
                    for (int i = 0; i < 8; ++i) { a[i] += xv[i]; ss += a[i] * a[i]; }
                    *(u32x4*)(H1B + row * 1024 + c) = pack8(a);
                }
                ss = xsum_fq(ss);
                if (fq == 0) SSQ[row * 16 + u.pn * 4 + wc] = ss;
            }
            asm volatile("" ::: "memory"); }
    }
};
struct EpiGateUp {
    static constexpr bool PERM = true, AFTER_DRAIN = false; static constexpr int MID_T = 0;
    const float* SSQ; bf16* ACT;
    __device__ __forceinline__ void operator()(EPI_ARGS) const {
        const int row0 = u.pm * 256 + wr * 64 + fr, c0 = u.pn * 128 + wc * 32 + 8 * fq;
        f32x4 sq[2][4];
#pragma unroll
        for (int ai = 0; ai < 2; ++ai)
#pragma unroll
            for (int m = 0; m < 4; ++m) sq[ai][m] = *(const f32x4*)(SSQ + (size_t)(row0 + ai * 128 + m * 16) * 16 + 4 * fq);
        asm volatile("" ::: "memory");
#pragma unroll
        for (int ai = 0; ai < 2; ++ai)
#pragma unroll
            for (int m = 0; m < 4; ++m) {
                const size_t row = (size_t)(row0 + ai * 128 + m * 16);
                const f32x4 s0 = sq[ai][m];
                const float tot = xsum_fq((s0[0] + s0[1]) + (s0[2] + s0[3]));
                const float rs = rsqrtf(tot * (1.0f / 1024.0f) + 1e-6f);
                float gt[8], up[8]; acc8(acc, ai, 0, m, gt); acc8(acc, ai, 1, m, up);
#pragma unroll
                for (int i = 0; i < 8; ++i) { const float gv = gt[i] * rs; gt[i] = gv * sigmoidf_(gv) * (up[i] * rs); }
                *(u32x4*)(ACT + row * FFH + c0) = pack8(gt);
            }
    }
};
struct EpiDown {
    static constexpr bool PERM = true, AFTER_DRAIN = false; static constexpr int MID_T = 0;
    float* out; const bf16* H1B;
    __device__ __forceinline__ void operator()(EPI_ARGS) const {
        const int row0 = u.pm * 256 + wr * 64 + fr, c0 = u.pn * 256 + wc * 32 + 8 * fq;
#pragma unroll
        for (int ai = 0; ai < 2; ++ai) { u32x4 hw[4][2];
#pragma unroll
            for (int m = 0; m < 4; ++m)
#pragma unroll
                for (int bj = 0; bj < 2; ++bj) hw[m][bj] = *(const u32x4*)(H1B + (size_t)(row0 + ai * 128 + m * 16) * 1024 + c0 + bj * 128);
            asm volatile("" ::: "memory");
#pragma unroll
            for (int m = 0; m < 4; ++m)
#pragma unroll
                for (int bj = 0; bj < 2; ++bj) {
                    float a[8], h[8]; acc8(acc, ai, bj, m, a); const size_t off = (size_t)(row0 + ai * 128 + m * 16) * 1024 + c0 + bj * 128; unpack8(hw[m][bj], h);
#pragma unroll
                    for (int i = 0; i < 8; ++i) a[i] += h[i];
                    st8f(out + off, a);
                }
            asm volatile("" ::: "memory"); }
    }
};
struct WRow { const float* W; int ld, sc, koff, kcnt; };
__device__ __forceinline__ WRow wrow(const Frame& F, int mat, int n) {
    WRow r; r.koff = 0;
    switch (mat) {
    case 0: { r.W = F.in[2]; r.ld = IN_W; r.kcnt = 1024; const int pn = n >> 8, c = n & 255;
        if (pn < 4) { const int head = 4 * (pn & 1) + ((c >> 5) & 3), dim = ((c >> 7) << 5) + (c & 31); r.sc = (pn >> 1) * 512 + head * 64 + dim; }
        else if (pn < 8) r.sc = n;
        else if (pn < 16) { const int cr = n - 2048; r.sc = cr < RWW ? 2120 + cr : (cr < RWW + 64 ? 2048 + (cr - RWW) : (cr < RWW + 72 ? 2112 + (cr - RWW - 64) : -1)); }
        else { const int c = n & 255; r.sc = 3944 + (c < 128 ? 0 : 1024) + 128 * (pn - 16) + (c & 127); }
        break; }
    case 1: r.W = F.in[17]; r.ld = 1024; r.kcnt = 512; r.sc = n; break;
    case 3: r.W = F.in[19]; r.ld = 1024; r.kcnt = 1024; r.sc = n; break;
    case 4: { r.W = F.in[21]; r.ld = 2 * FFH; r.kcnt = 1024; const int pn = n >> 8, c = n & 255; r.sc = c < 128 ? 128 * pn + c : FFH + 128 * pn + (c - 128); break; }
    case 5: r.W = F.in[22]; r.ld = 1024; r.kcnt = FFH; r.sc = n; break;
    default: { r.ld = 512; if (n < 512) { r.W = F.in[8]; r.sc = n; r.koff = 0; r.kcnt = 64; } else if (n < 1024) { r.W = F.in[10]; r.sc = n - 512; r.koff = 64; r.kcnt = 64; } else { r.W = F.in[11]; r.sc = n - 1024; r.koff = 128; r.kcnt = 160; } break; }
    }
    return r;
}
struct P0Dec { int mat, Kout, nblk, r; bf16* WT; const float* scale; };
__device__ __forceinline__ P0Dec p0_dec(const Frame& F, int it) {
    constexpr int I0 = 16 * (NPROJ / 32), I1 = 16 * 32, I3 = 16 * 32, I4 = 16 * (2 * FFH / 32), I5 = (FFH / 64) * 32;
    unsigned char* ws = F.ws; P0Dec d; d.scale = nullptr; int r = it;
    if (r < I0) { d.mat = 0; d.Kout = 1024; d.nblk = NPROJ / 32; d.WT = (bf16*)(ws + WS_WIN); d.r = r; return d; } r -= I0;
    if (r < I1) { d.mat = 1; d.Kout = 1024; d.nblk = 32; d.WT = (bf16*)(ws + WS_WBA); d.r = r; return d; } r -= I1;
    if (r < I3) { d.mat = 3; d.Kout = 1024; d.nblk = 32; d.WT = (bf16*)(ws + WS_WO); d.r = r; return d; } r -= I3;
    if (r < I4) { d.mat = 4; d.Kout = 1024; d.nblk = 2 * FFH / 32; d.WT = (bf16*)(ws + WS_WGU); d.scale = F.in[20]; d.r = r; return d; } r -= I4;
    if (r < I5) { d.mat = 5; d.Kout = FFH; d.nblk = 32; d.WT = (bf16*)(ws + WS_WD); d.r = r; return d; } r -= I5;
    d.mat = 6; d.Kout = LK; d.nblk = LN_ / 32; d.WT = (bf16*)(ws + WS_WL); d.r = r; return d;
}
__device__ __forceinline__ void p0_load(const Frame& F, const P0Dec& d, float (&v)[32], f32x4 (&sv)[2]) {
    const int lane = F.lane, kb = d.r / d.nblk, nb = d.r % d.nblk, k0 = 64 * kb, n0 = 32 * nb;
    WRow r = wrow(F, d.mat, n0 + (lane & 31));
    if (d.mat == 1 && k0 >= 512) { r.W = F.in[18]; r.koff = 512; }
#pragma unroll
    for (int i = 0; i < 32; ++i) { const int kk = 2 * i + (lane >> 5), ks = k0 + kk - r.koff; v[i] = 0.f;
        if (r.sc >= 0 && ks >= 0 && ks < r.kcnt) v[i] = r.W[(size_t)ks * r.ld + r.sc]; }
    sv[0] = (f32x4){1.f, 1.f, 1.f, 1.f}; sv[1] = sv[0];
    if (d.scale) { const f32x4* sp = (const f32x4*)(d.scale + k0 + 8 * (lane & 7)); sv[0] = sp[0]; sv[1] = sp[1]; }
}
__device__ __forceinline__ void p0_store(const Frame& F, const P0Dec& d, const float (&v)[32], const f32x4 (&sv)[2], LAS float* scr) {
    const int lane = F.lane, kb = d.r / d.nblk, nb = d.r % d.nblk, k0 = 64 * kb, n0 = 32 * nb;
#pragma unroll
    for (int i = 0; i < 32; ++i) scr[(2 * i + (lane >> 5)) * 33 + (lane & 31)] = v[i];
    asm volatile("s_waitcnt lgkmcnt(0)" ::: "memory");
    const int c = lane & 7;
#pragma unroll
    for (int j = 0; j < 4; ++j) { const int n = (lane >> 3) + 8 * j; const LAS float* s = scr + (8 * c) * 33 + n;
        u32x4 o; o.x = pk2(s[0 * 33] * sv[0][0], s[1 * 33] * sv[0][1]); o.y = pk2(s[2 * 33] * sv[0][2], s[3 * 33] * sv[0][3]);
        o.z = pk2(s[4 * 33] * sv[1][0], s[5 * 33] * sv[1][1]); o.w = pk2(s[6 * 33] * sv[1][2], s[7 * 33] * sv[1][3]);
        *(u32x4*)(d.WT + (size_t)(n0 + n) * d.Kout + k0 + 8 * c) = o; }
    asm volatile("s_waitcnt lgkmcnt(0)" ::: "memory");
}
__device__ __forceinline__ float wave_sum(float v) {
#pragma unroll
    for (int o = 1; o < 64; o <<= 1) v += __shfl_xor(v, o);
    return v;
}
__device__ __forceinline__ void phase_p0(const Frame& F) {
    LAS float* scr = (LAS float*)(F.lds + F.wave * 16384);
    const int gw = F.vcu * 8 + F.wave, NGW = F.G * 8;
    constexpr int I0 = 16 * (NPROJ / 32), I1 = 16 * 32, I2 = 0, I3 = 16 * 32, I4 = 16 * (2 * FFH / 32), I5 = (FFH / 64) * 32, I6 = (LK / 64) * (LN_ / 32);
    constexpr int NITEMS = I0 + I1 + I2 + I3 + I4 + I5 + I6;
    unsigned char* ws = F.ws;
    {
        float va[32], vb[32]; f32x4 sa[2], sb[2]; P0Dec da, db;
        if (gw < NITEMS) { da = p0_dec(F, gw); p0_load(F, da, va, sa); }
#pragma unroll 1
        for (int it = gw; it < NITEMS; it += NGW) {
            const bool hb = it + NGW < NITEMS;
            if (hb) { db = p0_dec(F, it + NGW); p0_load(F, db, vb, sb); }
            p0_store(F, da, va, sa, scr);
            if (hb) { da = db; sa[0] = sb[0]; sa[1] = sb[1];
#pragma unroll
                for (int i = 0; i < 32; ++i) va[i] = vb[i]; }
        }
    }
    const float* gain = F.in[1]; bf16* XN = (bf16*)(ws + WS_XN);
    f32x4 gv[4];
#pragma unroll
    for (int j = 0; j < 4; ++j) gv[j] = *((const f32x4*)gain + F.lane + 64 * j);
    f32x4 v[4][4], vn[4][4];
#define P0_XLOAD(dst, mm) _Pragma("unroll") for (int q = 0; q < 4; ++q) { const f32x4* xr = (const f32x4*)(F.in[0] + (size_t)((mm) + q) * DM) + F.lane; \
            _Pragma("unroll") for (int j = 0; j < 4; ++j) dst[q][j] = xr[64 * j]; }
    if (4 * gw < T) P0_XLOAD(v, 4 * gw);
#pragma unroll 1
    for (int m0 = 4 * gw; m0 < T; m0 += 4 * NGW) {
        const bool hn = m0 + 4 * NGW < T;
        if (hn) P0_XLOAD(vn, m0 + 4 * NGW);
        float s[4];
#pragma unroll
        for (int q = 0; q < 4; ++q) { s[q] = 0.f;
#pragma unroll
            for (int j = 0; j < 4; ++j) s[q] += (v[q][j][0] * v[q][j][0] + v[q][j][1] * v[q][j][1]) + (v[q][j][2] * v[q][j][2] + v[q][j][3] * v[q][j][3]); }
#pragma unroll
        for (int o = 1; o < 64; o <<= 1) {
#pragma unroll
            for (int q = 0; q < 4; ++q) s[q] += __shfl_xor(s[q], o); }
#pragma unroll
        for (int q = 0; q < 4; ++q) { const float rs = rsqrtf(s[q] * (1.0f / DM) + 1e-6f); u32x2* o = (u32x2*)(XN + (size_t)(m0 + q) * DM) + F.lane;
#pragma unroll
            for (int j = 0; j < 4; ++j) { u32x2 w; w.x = pk2(v[q][j][0] * rs * gv[j][0], v[q][j][1] * rs * gv[j][1]); w.y = pk2(v[q][j][2] * rs * gv[j][2], v[q][j][3] * rs * gv[j][3]); o[64 * j] = w; } }
        if (hn) {
#pragma unroll
            for (int q = 0; q < 4; ++q) {
#pragma unroll
                for (int j = 0; j < 4; ++j) v[q][j] = vn[q][j]; } }
    }
#undef P0_XLOAD
}
__device__ __forceinline__ void phase_pr1(const Frame& F) {
    const bf16* Z = (const bf16*)(F.ws + WS_Z); bf16* A12 = (bf16*)(F.ws + WS_A12); const float* mu = F.in[6];
    if (F.tid >= 480) return;
    const int rsub = F.tid / 48, c = 192 + F.tid % 48;
    if (c >= 228) {
        for (int m0 = 4 * (10 * F.vcu + rsub); m0 < T; m0 += 40 * F.G) {
#pragma unroll
            for (int q = 0; q < 4; ++q) *(u32x4*)(A12 + (size_t)(m0 + q) * LK + 288 + 8 * (c - 228)) = (u32x4){0u, 0u, 0u, 0u}; }
        return;
    }
    float muv[8]; ld8f(mu + 8 * c, muv);
    const int col = 8 * c;
    for (int m0 = 4 * (10 * F.vcu + rsub); m0 < T; m0 += 40 * F.G) {
        u32x4 raw[5]; raw[0] = (u32x4){0u, 0u, 0u, 0u}; if ((m0 & (SEQ - 1)) != 0) raw[0] = *(const u32x4*)(Z + (size_t)(m0 - 1) * RWW + col);
#pragma unroll
        for (int q = 0; q < 4; ++q) raw[q + 1] = *(const u32x4*)(Z + (size_t)(m0 + q) * RWW + col);
        float zp[8]; unpack8(raw[0], zp);
#pragma unroll
        for (int q = 0; q < 4; ++q) {
            const int m = m0 + q; float zc[8], z[8]; unpack8(raw[q + 1], zc);
#pragma unroll
            for (int i = 0; i < 8; ++i) { z[i] = zc[i] + muv[i] * (zp[i] - zc[i]); zp[i] = zc[i]; }
            if (col < 1600) {
#pragma unroll
                for (int i = 0; i < 8; ++i) z[i] = 1.0f - 2.0f * __builtin_amdgcn_rcpf(1.0f + __expf(2.0f * z[i]));
                *(u32x4*)(A12 + (size_t)m * LK + (col - 1536)) = pack8(z);
            } else if (col < 1664) *(u32x4*)(A12 + (size_t)m * LK + 64 + (col - 1600)) = pack8(z);
            else {
#pragma unroll
                for (int i = 0; i < 8; ++i) z[i] = sigmoidf_(z[i]);
                *(u32x4*)(A12 + (size_t)m * LK + 128 + (col - 1664)) = pack8(z);
            }
        }
    }
}
__device__ __forceinline__ float sum8(float v) { v += __shfl_xor(v, 1); v += __shfl_xor(v, 2); v += __shfl_xor(v, 4); return v; }
__device__ __forceinline__ void phase_pr2(const Frame& F) {
    bf16* RKV = (bf16*)(F.ws + WS_RKV); const bf16* AA = (const bf16*)(F.ws + WS_AA); bf16* KK = (bf16*)(F.ws + WS_KK); bf16* BB = (bf16*)(F.ws + WS_BB);
    const int gw = F.vcu * 8 + F.wave, NGW = F.G * 8, l = F.lane;
    float kkw[8], kaw[8]; ld8f(F.in[12] + 8 * l, kkw); ld8f(F.in[13] + 8 * l, kaw);
    for (int m = gw; m < T; m += NGW) {
        float k[8], a[8], kk[8], b[8]; unpack8(*(const u32x4*)(RKV + (size_t)m * 1536 + 512 + 8 * l), k); unpack8(*(const u32x4*)(AA + (size_t)m * 512 + 8 * l), a);
        float ss = 0.f;
#pragma unroll
        for (int i = 0; i < 8; ++i) { kk[i] = k[i] * kkw[i]; ss += kk[i] * kk[i]; }
        ss = sum8(ss);
        const float inv = 1.0f / fmaxf(sqrtf(ss), 1e-12f);
#pragma unroll
        for (int i = 0; i < 8; ++i) { kk[i] *= inv; b[i] = kk[i] * a[i]; k[i] = k[i] * (1.0f + (a[i] - 1.0f) * kaw[i]); }
        *(u32x4*)(KK + (size_t)m * 512 + 8 * l) = pack8(kk); *(u32x4*)(BB + (size_t)m * 512 + 8 * l) = pack8(b); *(u32x4*)(RKV + (size_t)m * 1536 + 512 + 8 * l) = pack8(k);
    }
}
__device__ __forceinline__ void phase_post(const Frame& F) {
    const bf16* Y = (const bf16*)(F.ws + WS_Y); const bf16* GG = (const bf16*)(F.ws + WS_GG); const bf16* BV = (const bf16*)(F.ws + WS_BV); bf16* YA2 = (bf16*)(F.ws + WS_YA2);
    const int gw = F.vcu * 8 + F.wave, NGW = F.G * 8, l = F.lane;
    float lw[8], lb[8]; ld8f(F.in[15] + 8 * l, lw); ld8f(F.in[16] + 8 * l, lb);
    u32x4 ry[2], rb[2], rg[2];
#pragma unroll
    for (int q = 0; q < 2; ++q) { const size_t o = (size_t)(2 * gw + q) * 512 + 8 * l; ry[q] = *(const u32x4*)(Y + o); rb[q] = *(const u32x4*)(BV + o); rg[q] = *(const u32x4*)(GG + o); }
    for (int m0 = 2 * gw; m0 < T; m0 += 2 * NGW) {
        u32x4 ny[2], nb[2], ng[2]; const int mn = m0 + 2 * NGW < T ? m0 + 2 * NGW : m0;
#pragma unroll
        for (int q = 0; q < 2; ++q) { const size_t o = (size_t)(mn + q) * 512 + 8 * l; ny[q] = *(const u32x4*)(Y + o); nb[q] = *(const u32x4*)(BV + o); ng[q] = *(const u32x4*)(GG + o); }
#pragma unroll
        for (int q = 0; q < 2; ++q) {
            float y[8], bv[8], g[8]; unpack8(ry[q], y); unpack8(rb[q], bv); unpack8(rg[q], g);
            float s = 0.f;
#pragma unroll
            for (int i = 0; i < 8; ++i) s += y[i];
            s = sum8(s);
            const float mean = s * (1.0f / 64.0f); float qq = 0.f;
#pragma unroll
            for (int i = 0; i < 8; ++i) { y[i] -= mean; qq += y[i] * y[i]; }
            qq = sum8(qq);
            const float rs = rsqrtf(qq * (1.0f / 64.0f) + 64e-5f);
#pragma unroll
            for (int i = 0; i < 8; ++i) y[i] = ((y[i] * rs) * lw[i] + lb[i] + bv[i]) * g[i];
            *(u32x4*)(YA2 + (size_t)(m0 + q) * 1024 + 512 + 8 * l) = pack8(y);
        }
#pragma unroll
        for (int q = 0; q < 2; ++q) { ry[q] = ny[q]; rb[q] = nb[q]; rg[q] = ng[q]; }
    }
}
#define DPP_ADD(x, ctrl) x += __builtin_bit_cast(float, __builtin_amdgcn_update_dpp(0, __builtin_bit_cast(int, x), ctrl, 0xf, 0xf, true))
__device__ __forceinline__ float rowsum16(float x) { DPP_ADD(x, 0xB1); DPP_ADD(x, 0x4E); DPP_ADD(x, 0x141); DPP_ADD(x, 0x140); return x; }
namespace scn { constexpr int CH = 32, STEP_F = 5 * 64 + 16, BUF_F = CH * STEP_F; }
__device__ __forceinline__ void phase_scan(const Frame& F) {
    using namespace scn;
#define SC_BAR() asm volatile("s_waitcnt lgkmcnt(0)\n\ts_barrier" ::: "memory")
    typedef float f32x2 __attribute__((ext_vector_type(2)));
    const bf16* RKV = (const bf16*)(F.ws + WS_RKV); const bf16* KK = (const bf16*)(F.ws + WS_KK); const bf16* BB = (const bf16*)(F.ws + WS_BB);
    const float* DEC = (const float*)(F.ws + WS_XN); bf16* Y = (bf16*)(F.ws + WS_Y);
    const int bh = F.vcu >> 2, b = bh >> 3, h = bh & 7, vq0 = (F.vcu & 3) * 16;
    const size_t mb = (size_t)b * SEQ;
    LAS float* ring = (LAS float*)F.lds;
    constexpr int NCH = SEQ / CH;
    __syncthreads();
    if (F.wave >= 4) {
        const int lt = F.tid - 256, st = lt >> 3, e8 = lt & 7;
        const bf16* pR = RKV + (mb + st) * 1536 + h * 64 + 8 * e8; const bf16* pK = pR + 512;
        const bf16* pKK = KK + (mb + st) * 512 + h * 64 + 8 * e8; const bf16* pB = BB + (mb + st) * 512 + h * 64 + 8 * e8;
        const float* pD = DEC + (mb + st) * 512 + h * 64 + 8 * e8;
        const int vs = lt >> 3, ve = (lt & 7) * 2;
        const bf16* pV = RKV + (mb + vs) * 1536 + 1024 + h * 64 + vq0 + ve;
        u32x4 gk, gb, gc, gr; f32x4 gd0, gd1; unsigned gv;
#define SC_LOAD(c) do { const size_t o_ = (size_t)(c) * CH; gk = *(const u32x4*)(pKK + o_ * 512); gb = *(const u32x4*)(pB + o_ * 512); gc = *(const u32x4*)(pK + o_ * 1536); gr = *(const u32x4*)(pR + o_ * 1536); \
            gd0 = *(const f32x4*)(pD + o_ * 512); gd1 = *(const f32x4*)(pD + o_ * 512 + 4); gv = *(const unsigned*)(pV + o_ * 1536); } while (0)
#define SC_W8(dst, q_) do { *(LAS f32x4*)(dst) = (f32x4){bflo((q_)[0]), bfhi((q_)[0]), bflo((q_)[1]), bfhi((q_)[1])}; *(LAS f32x4*)((dst) + 4) = (f32x4){bflo((q_)[2]), bfhi((q_)[2]), bflo((q_)[3]), bfhi((q_)[3])}; } while (0)
#define SC_STORE(buf) do { LAS float* d_ = ring + (buf) * BUF_F + st * STEP_F + 8 * e8; SC_W8(d_, gk); SC_W8(d_ + 64, gb); SC_W8(d_ + 128, gc); SC_W8(d_ + 192, gr); \
            *(LAS f32x4*)(d_ + 256) = gd0; *(LAS f32x4*)(d_ + 260) = gd1; LAS float* v_ = ring + (buf) * BUF_F + vs * STEP_F + 320 + ve; v_[0] = bflo(gv); v_[1] = bfhi(gv); } while (0)
        SC_LOAD(0); SC_STORE(0); SC_LOAD(1);
        SC_BAR();
        for (int c = 0; c < NCH; ++c) {
            if (c + 1 < NCH) { SC_STORE((c + 1) & 1); if (c + 2 < NCH) SC_LOAD(c + 2); }
            SC_BAR();
        }
#undef SC_LOAD
#undef SC_W8
#undef SC_STORE
    } else {
        const int rr = F.lane >> 4, kp = F.lane & 15, vl = 4 * F.wave + rr;
        bf16* pY = Y + (mb + kp) * 512 + h * 64 + vq0 + vl;
        f32x2 S01 = {0.f, 0.f}, S23 = {0.f, 0.f};
        struct StepIn { f32x4 kk, bb, kc, rc, dc; float vv; };
#define SC_RD(dst, p_, vp_) do { (dst).kk = *(const LAS f32x4*)(p_); (dst).bb = *(const LAS f32x4*)((p_) + 64); (dst).kc = *(const LAS f32x4*)((p_) + 128); (dst).rc = *(const LAS f32x4*)((p_) + 192); \
            (dst).dc = *(const LAS f32x4*)((p_) + 256); (dst).vv = *(vp_); } while (0)
#define SC_UPD(in) do { const f32x2 sa2_ = {sa_cur, sa_cur}, vv2_ = {(in).vv, (in).vv}; \
            S01 = S01 * (f32x2){(in).dc[0], (in).dc[1]} + (sa2_ * (f32x2){(in).bb[0], (in).bb[1]} + vv2_ * (f32x2){(in).kc[0], (in).kc[1]}); \
            S23 = S23 * (f32x2){(in).dc[2], (in).dc[3]} + (sa2_ * (f32x2){(in).bb[2], (in).bb[3]} + vv2_ * (f32x2){(in).kc[2], (in).kc[3]}); } while (0)
#define SC_DUAL(in_c, in_n, sidx) do { \
            const f32x2 t1_ = S01 * (f32x2){(in_c).rc[0], (in_c).rc[1]} + S23 * (f32x2){(in_c).rc[2], (in_c).rc[3]}; \
            const f32x2 t0_ = S01 * (f32x2){(in_n).kk[0], (in_n).kk[1]} + S23 * (f32x2){(in_n).kk[2], (in_n).kk[3]}; \
            float y_ = t1_[0] + t1_[1], sa_ = t0_[0] + t0_[1]; \
            DPP_ADD(sa_, 0xB1); DPP_ADD(y_, 0xB1); DPP_ADD(sa_, 0x4E); DPP_ADD(y_, 0x4E); DPP_ADD(sa_, 0x141); DPP_ADD(y_, 0x141); DPP_ADD(sa_, 0x140); DPP_ADD(y_, 0x140); \
            sa_cur = -sa_; ykeep = (kp == ((sidx) & 15)) ? y_ : ykeep; } while (0)
#define SC_SOLO_SA(in_n) do { const f32x2 t0_ = S01 * (f32x2){(in_n).kk[0], (in_n).kk[1]} + S23 * (f32x2){(in_n).kk[2], (in_n).kk[3]}; float sa_ = t0_[0] + t0_[1]; sa_cur = -rowsum16(sa_); } while (0)
#define SC_SOLO_Y(in_c, sidx) do { const f32x2 t1_ = S01 * (f32x2){(in_c).rc[0], (in_c).rc[1]} + S23 * (f32x2){(in_c).rc[2], (in_c).rc[3]}; float y_ = t1_[0] + t1_[1]; y_ = rowsum16(y_); \
            ykeep = (kp == ((sidx) & 15)) ? y_ : ykeep; } while (0)
        SC_BAR();
        float ykeep = 0.f, sa_cur = 0.f;
        for (int c = 0; c < NCH; ++c) {
            const LAS float* base = ring + (c & 1) * BUF_F + 4 * kp;
            const LAS float* vbase = ring + (c & 1) * BUF_F + 320 + vl;
            StepIn A0, A1, A2, A3, B0, B1, B2, B3;
            SC_RD(A0, base, vbase); SC_RD(A1, base + STEP_F, vbase + STEP_F); SC_RD(A2, base + 2 * STEP_F, vbase + 2 * STEP_F); SC_RD(A3, base + 3 * STEP_F, vbase + 3 * STEP_F);
            SC_SOLO_SA(A0);
#pragma unroll 1
            for (int s = 0; s < CH; s += 8) {
                const LAS float* pb = base + (s + 4) * STEP_F; const LAS float* vb_ = vbase + (s + 4) * STEP_F;
                SC_RD(B0, pb, vb_); SC_RD(B1, pb + STEP_F, vb_ + STEP_F); SC_RD(B2, pb + 2 * STEP_F, vb_ + 2 * STEP_F); SC_RD(B3, pb + 3 * STEP_F, vb_ + 3 * STEP_F);
                SC_UPD(A0); SC_DUAL(A0, A1, s); SC_UPD(A1); SC_DUAL(A1, A2, s + 1); SC_UPD(A2); SC_DUAL(A2, A3, s + 2); SC_UPD(A3); SC_DUAL(A3, B0, s + 3);
                const bool more = (s + 8 < CH);
                if (more) { const LAS float* pa = base + (s + 8) * STEP_F; const LAS float* va_ = vbase + (s + 8) * STEP_F;
                    SC_RD(A0, pa, va_); SC_RD(A1, pa + STEP_F, va_ + STEP_F); SC_RD(A2, pa + 2 * STEP_F, va_ + 2 * STEP_F); SC_RD(A3, pa + 3 * STEP_F, va_ + 3 * STEP_F); }
                SC_UPD(B0); SC_DUAL(B0, B1, s + 4); SC_UPD(B1); SC_DUAL(B1, B2, s + 5); SC_UPD(B2); SC_DUAL(B2, B3, s + 6); SC_UPD(B3);
                if (more) SC_DUAL(B3, A0, s + 7); else SC_SOLO_Y(B3, s + 7);
                if ((s & 8) != 0) pY[(size_t)(c * CH + s - 8) * 512] = (bf16)f2bf(ykeep);
            }
            SC_BAR();
        }
#undef SC_RD
#undef SC_UPD
#undef SC_DUAL
#undef SC_SOLO_SA
#undef SC_SOLO_Y
    }
}
#define CNT4_GE(c_, cand_, a0_, a1_, a2_, a3_) do { unsigned long long m0_, m1_, m2_, m3_; \
        asm volatile("v_cmp_le_u32_e64 %1, %5, %6\n\tv_cmp_le_u32_e64 %2, %5, %7\n\tv_cmp_le_u32_e64 %3, %5, %8\n\tv_cmp_le_u32_e64 %4, %5, %9\n\t" \
                     "v_addc_co_u32_e64 %0, %1, 0, %0, %1\n\tv_addc_co_u32_e64 %0, %2, 0, %0, %2\n\tv_addc_co_u32_e64 %0, %3, 0, %0, %3\n\tv_addc_co_u32_e64 %0, %4, 0, %0, %4" \
                     : "+v"(c_), "=&s"(m0_), "=&s"(m1_), "=&s"(m2_), "=&s"(m3_) : "s"(cand_), "v"(a0_), "v"(a1_), "v"(a2_), "v"(a3_)); } while (0)
__device__ __forceinline__ int wave_isum(int v) {
#define DPP_IADD(x, ctrl) x += __builtin_amdgcn_update_dpp(0, x, ctrl, 0xf, 0xf, true)
    DPP_IADD(v, 0xB1); DPP_IADD(v, 0x4E); DPP_IADD(v, 0x141); DPP_IADD(v, 0x140);
#undef DPP_IADD
    return __builtin_amdgcn_readlane(v, 0) + __builtin_amdgcn_readlane(v, 16) + __builtin_amdgcn_readlane(v, 32) + __builtin_amdgcn_readlane(v, 48);
}
__device__ __forceinline__ unsigned bs_bfi(unsigned m, unsigned a, unsigned b) { return (m & a) | (~m & b); }
template <int OFF, int N> __device__ __forceinline__ void bs_transpose32(unsigned (&a)[N]) {
#define BS_STAGE(J, M) _Pragma("unroll") for (int k0 = 0; k0 < 32; k0 += 2 * (J)) { _Pragma("unroll") for (int k1 = 0; k1 < (J); ++k1) { const int k = OFF + k0 + k1; \
        const unsigned lo = a[k], hi = a[k + (J)]; a[k] = bs_bfi((M), lo, hi << (J)); a[k + (J)] = bs_bfi((M), lo >> (J), hi); } }
    BS_STAGE(16, 0x0000FFFFu) BS_STAGE(8, 0x00FF00FFu) BS_STAGE(4, 0x0F0F0F0Fu) BS_STAGE(2, 0x33333333u) BS_STAGE(1, 0x55555555u)
#undef BS_STAGE
}
template <int NR> __device__ __forceinline__ void bs_transpose_h(unsigned (&a)[NR]) {
#define BS_STAGE(J, M) _Pragma("unroll") for (int k0 = 0; k0 < NR; k0 += 2 * (J)) { _Pragma("unroll") for (int k1 = 0; k1 < (J); ++k1) { const int k = k0 + k1; \
        const unsigned lo = a[k], hi = a[k + (J)]; a[k] = bs_bfi((M), lo, hi << (J)); a[k + (J)] = bs_bfi((M), lo >> (J), hi); } }
    if (NR == 32) { BS_STAGE(16, 0x0000FFFFu) }
    BS_STAGE(8, 0x00FF00FFu) BS_STAGE(4, 0x0F0F0F0Fu) BS_STAGE(2, 0x33333333u) BS_STAGE(1, 0x55555555u)
#undef BS_STAGE
}
__device__ __forceinline__ unsigned bs_spread16(unsigned x) { x = (x | (x << 8)) & 0x00FF00FFu; x = (x | (x << 4)) & 0x0F0F0F0Fu; x = (x | (x << 2)) & 0x33333333u; x = (x | (x << 1)) & 0x55555555u; return x; }
__device__ __forceinline__ unsigned bs_inter16(unsigned e, unsigned o) { return bs_spread16(e & 0xFFFFu) | (bs_spread16(o & 0xFFFFu) << 1); }
template <int NW> __device__ __forceinline__ void idx_select_h(const Frame& F, const unsigned* rowu, const int p, const int jng, unsigned long long* mrow) {
    constexpr int K = 32 * NW, NR = K / 2;
    const int lane = F.lane, kb = K * lane;
    unsigned a[NR];
    if (kb <= p) {
#pragma unroll
        for (int q = 0; q < NR / 4; ++q) { const u32x4 v = *(const u32x4*)(rowu + NR * lane + 4 * q);
#pragma unroll
            for (int e = 0; e < 4; ++e) { const unsigned w = v[e]; const unsigned m = (w >> 15) & 0x00010001u; a[4 * q + e] = w ^ (((m << 15) - m) | 0x80008000u); } }
    } else {
#pragma unroll
        for (int i = 0; i < NR; ++i) a[i] = 0u; }
    int nv = p - kb + 1; nv = nv < 0 ? 0 : (nv > K ? K : nv);
    const int ne = (nv + 1) >> 1, no = nv >> 1;
    const unsigned VE = ne >= 32 ? 0xFFFFFFFFu : ((1u << ne) - 1u), VO = no >= 32 ? 0xFFFFFFFFu : ((1u << no) - 1u);
    unsigned A0, A1, S0 = 0u, S1 = 0u;
    if (NW == 2) { A0 = VE; A1 = VO; } else { A0 = VE | (VO << 16); A1 = 0u; }
    bool ties = false; int need = 0;
    if (p >= 256) {
        bs_transpose_h<NR>(a);
        int G = 0; bool exact = false;
#pragma unroll
        for (int b = 15; b >= 0; --b) {
            const unsigned o0 = A0 & a[b], o1 = (NW == 2) ? (A1 & a[(NW == 2 ? 16 : 0) + b]) : 0u;
            const int t = G + wave_isum(__builtin_popcount(o0) + __builtin_popcount(o1));
            if (t >= 256) { A0 = o0; A1 = o1; if (t == 256) { exact = true; break; } }
            else { G = t; S0 |= o0; S1 |= o1; A0 ^= o0; A1 ^= o1; }
        }
        need = 256 - G;
        if (!exact) { const int ce = wave_isum(__builtin_popcount(A0) + __builtin_popcount(A1)); ties = (ce != need); }
    }
    unsigned mS_lo, mS_hi, mA_lo, mA_hi;
    if (NW == 2) { mS_lo = bs_inter16(S0, S1); mS_hi = bs_inter16(S0 >> 16, S1 >> 16); mA_lo = bs_inter16(A0, A1); mA_hi = bs_inter16(A0 >> 16, A1 >> 16); }
    else { mS_lo = bs_inter16(S0, S0 >> 16); mS_hi = 0u; mA_lo = bs_inter16(A0, A0 >> 16); mA_hi = 0u; }
    if (!ties) { mS_lo |= mA_lo; mS_hi |= mA_hi; }
    else {
        const int cl = __builtin_popcount(mA_lo) + __builtin_popcount(mA_hi); int inc = cl;
#pragma unroll
        for (int o = 1; o < 64; o <<= 1) { const int y = __shfl_up(inc, o); if (lane >= o) inc += y; }
        int r = need - (inc - cl); r = r < 0 ? 0 : (r > cl ? cl : r);
        unsigned long long x = ((unsigned long long)mA_hi << 32) | (unsigned long long)mA_lo;
        while (r > 0) { const unsigned long long low = x & (~x + 1ull); mS_lo |= (unsigned)low; mS_hi |= (unsigned)(low >> 32); x ^= low; --r; }
    }
    if (NW == 2) { if (lane < jng) mrow[(size_t)lane * SEQ] = ((unsigned long long)mS_hi << 32) | (unsigned long long)mS_lo; }
    else { if (lane < 2 * jng) ((unsigned*)(mrow + (size_t)(lane >> 1) * SEQ))[lane & 1] = mS_lo; }
}
__device__ __forceinline__ float relu1(float x) { const int i = __builtin_bit_cast(int, x); return __builtin_bit_cast(float, i > 0 ? i : 0); }
__device__ __forceinline__ void phase_idx(const Frame& F) {
    const bf16* QI = (const bf16*)(F.ws + WS_QI); const bf16* KI = (const bf16*)(F.ws + WS_KI); const float* WI = (const float*)(F.ws + WS_WI);
    unsigned* SCRU = (unsigned*)(F.ws + WS_SCR) + (size_t)F.vcu * (32 * (SEQ / 2)); unsigned long long* MASK = (unsigned long long*)(F.ws + WS_MASK);
    const int lane = F.lane, wave = F.wave, r = lane & 31, hh = lane >> 5, g_ = r >> 2;
    const int qsel = 2 * (g_ & 1) + (g_ >> 2), hsel = 4 * ((g_ >> 1) & 1) + (r & 3);
    const int b = F.vcu >> 5, ii = F.vcu & 31;
    for (int gi = 0; gi < 4; ++gi) {
        const int g = gi == 0 ? ii : (gi == 1 ? 63 - ii : (gi == 2 ? 64 + ii : 127 - ii));
        const int p0 = 32 * g; const size_t mb = (size_t)b * SEQ; const size_t mq = mb + p0 + 4 * wave;
        bf16x8 a[4];
#pragma unroll
        for (int ks = 0; ks < 4; ++ks) a[ks] = *(const bf16x8*)(QI + (mq + qsel) * 512 + hsel * 64 + 16 * ks + 8 * hh);
        float wv[16];
#pragma unroll
        for (int qq = 0; qq < 2; ++qq) { const f32x4 w0 = *(const f32x4*)(WI + (mq + 2 * hh + qq) * 8), w1 = *(const f32x4*)(WI + (mq + 2 * hh + qq) * 8 + 4);
            wv[8 * qq + 0] = w0[0]; wv[8 * qq + 1] = w0[1]; wv[8 * qq + 2] = w0[2]; wv[8 * qq + 3] = w0[3]; wv[8 * qq + 4] = w1[0]; wv[8 * qq + 5] = w1[1]; wv[8 * qq + 6] = w1[2]; wv[8 * qq + 7] = w1[3]; }
        unsigned* srow = SCRU + (size_t)(4 * wave + 2 * hh) * (SEQ / 2);
        const int nkt = g + 1, nch = (nkt + 7) >> 3;
        const int skey = F.tid >> 3, sc = F.tid & 7;
        const bf16* ksrc = KI + (mb + skey) * 64 + 8 * sc;
        u32x4 st[4];
#define IDX_LOAD(ch) _Pragma("unroll") for (int i_ = 0; i_ < 4; ++i_) st[i_] = *(const u32x4*)(ksrc + (size_t)((ch) * 256 + 64 * i_) * 64)
#define IDX_STORE(buf) _Pragma("unroll") for (int i_ = 0; i_ < 4; ++i_) { const int row_ = 64 * i_ + 32 * (skey & 1) + (skey >> 1);     \
            *(LAS u32x4*)(F.lds + (buf) * 32768 + row_ * 128 + ((sc ^ ((row_ >> 1) & 7)) << 4)) = st[i_]; }
#define IDX_BAR() asm volatile("s_waitcnt lgkmcnt(0)\n\ts_barrier" ::: "memory")
        IDX_LOAD(0);
        IDX_BAR();
        IDX_STORE(0);
        if (nch > 1) IDX_LOAD(1);
        for (int ch = 0; ch < nch; ++ch) {
            IDX_BAR();
            const LAS unsigned char* cb = F.lds + (ch & 1) * 32768;
            bf16x8 bfA[2][4], bfB[2][4]; f32x16 accA[2], accB[2];
#define IDX_READ(bf_, tb_) _Pragma("unroll") for (int t2 = 0; t2 < 2; ++t2) { const int key = 32 * ((tb_) + t2) + r; const LAS unsigned char* kb = cb + key * 128; const int sw = (key >> 1) & 7; \
                _Pragma("unroll") for (int ks = 0; ks < 4; ++ks) bf_[t2][ks] = *(const LAS bf16x8*)(kb + (((2 * ks + hh) ^ sw) << 4)); }
#define IDX_MMA(acc_, bf_) { _Pragma("unroll") for (int t2 = 0; t2 < 2; ++t2) acc_[t2] = (f32x16){0.f, 0.f, 0.f, 0.f, 0.f, 0.f, 0.f, 0.f, 0.f, 0.f, 0.f, 0.f, 0.f, 0.f, 0.f, 0.f}; \
                _Pragma("unroll") for (int ks = 0; ks < 4; ++ks) { _Pragma("unroll") for (int t2 = 0; t2 < 2; ++t2) acc_[t2] = __builtin_amdgcn_mfma_f32_32x32x16_bf16(a[ks], bf_[t2][ks], acc_[t2], 0, 0, 0); } }
#define IDX_EPI(acc_, tb_) { float s_[2][2]; _Pragma("unroll") for (int t2 = 0; t2 < 2; ++t2) { float s0 = 0.f, s1 = 0.f; \
                _Pragma("unroll") for (int hd = 0; hd < 8; ++hd) { s0 = __builtin_fmaf(wv[hd], relu1(acc_[t2][hd]), s0); s1 = __builtin_fmaf(wv[8 + hd], relu1(acc_[t2][8 + hd]), s1); } s_[t2][0] = s0; s_[t2][1] = s1; } \
                const int ui = 128 * ch + 16 * (tb_) + r;                \
                srow[ui] = __builtin_bit_cast(unsigned, __builtin_amdgcn_cvt_pkrtz(s_[0][0], s_[1][0])); srow[SEQ / 2 + ui] = __builtin_bit_cast(unsigned, __builtin_amdgcn_cvt_pkrtz(s_[0][1], s_[1][1])); }
            IDX_READ(bfA, 0)
            IDX_MMA(accA, bfA) IDX_READ(bfB, 2)
            IDX_MMA(accB, bfB) IDX_READ(bfA, 4) IDX_EPI(accA, 0)
            IDX_MMA(accA, bfA) IDX_READ(bfB, 6) IDX_EPI(accB, 2)
            IDX_MMA(accB, bfB) IDX_EPI(accA, 4)
            IDX_EPI(accB, 6)
#undef IDX_READ
#undef IDX_MMA
#undef IDX_EPI
            if (ch + 1 < nch) { IDX_STORE((ch + 1) & 1); if (ch + 2 < nch) IDX_LOAD(ch + 2); }
        }
#undef IDX_LOAD
#undef IDX_STORE
#undef IDX_BAR
        asm volatile("s_waitcnt vmcnt(0)\n\tbuffer_inv sc1" ::: "memory");
        const int jng = ((p0 + 31) >> 6) + 1;
        if (jng <= 32) {
#pragma unroll 1
            for (int i = 0; i < 4; ++i) { const int p = p0 + 4 * wave + i; idx_select_h<1>(F, SCRU + (size_t)(4 * wave + i) * (SEQ / 2), p, jng, MASK + (size_t)(b * 64) * SEQ + p); }
        } else {
#pragma unroll 1
            for (int i = 0; i < 4; ++i) { const int p = p0 + 4 * wave + i; idx_select_h<2>(F, SCRU + (size_t)(4 * wave + i) * (SEQ / 2), p, jng, MASK + (size_t)(b * 64) * SEQ + p); }
        }
        asm volatile("s_waitcnt vmcnt(0)" ::: "memory");
    }
}
namespace att {
constexpr int L_K = 0, L_V = 24576, L_WS = 49152, L_OST = L_WS + 8 * 256, L_BT = L_OST + 8 * 4096, L_LUT = L_BT + 2048, L_END = L_LUT + 256;
__device__ __forceinline__ int crow(int r, int hi) { return (r & 3) + 8 * (r >> 2) + 4 * hi; }
typedef float f32x2_t __attribute__((ext_vector_type(2))); typedef __bf16 bf16x2_t __attribute__((ext_vector_type(2)));
__device__ __forceinline__ unsigned cvtpk(float lo, float hi) { f32x2_t v = {lo, hi}; bf16x2_t b = __builtin_convertvector(v, bf16x2_t); return __builtin_bit_cast(unsigned, b); }
__device__ __forceinline__ int t5_bucket(int d) {
    if (d < 16) return d;
    return 16 + (d >= 19) + (d >= 21) + (d >= 24) + (d >= 27) + (d >= 31) + (d >= 35) + (d >= 40) + (d >= 46) + (d >= 52) + (d >= 59) + (d >= 67) + (d >= 77) + (d >= 87) + (d >= 99) + (d >= 113);
}
}
__device__ __forceinline__ void phase_attn(const Frame& F) {
    using namespace att;
    const bf16* Qg = (const bf16*)(F.ws + WS_Q); const bf16* Kg = (const bf16*)(F.ws + WS_K); const bf16* Vg = (const bf16*)(F.ws + WS_V); bf16* Og = (bf16*)(F.ws + WS_YA2);
    const unsigned long long* MASK = (const unsigned long long*)(F.ws + WS_MASK); const float* relb = F.in[5];
    const int tid = F.tid, lane = F.lane, wid = F.wave, r32 = lane & 31, hi = lane >> 5;
    const int bh = F.vcu >> 2, b = bh >> 3, h = bh & 7, sx = F.vcu & 3;
    LAS unsigned char* lds = F.lds;
    LAS float* btab = (LAS float*)(lds + L_BT);
    LAS float* wsf = (LAS float*)(lds + L_WS) + wid * 64;
#define ATT_BAR() asm volatile("s_waitcnt lgkmcnt(0)\n\ts_barrier" ::: "memory")
    __syncthreads();
    { const int d_ = tid - 128, dd = d_ < 0 ? 0 : (d_ > 127 ? 127 : d_); const int bk = t5_bucket(dd); btab[tid] = (relb[bk * 8 + h] - relb[31 * 8 + h]) * LOG2E; }
    if (tid < 64) ((LAS float*)(lds + L_LUT))[tid] = (((tid >> 2) >> (tid & 3)) & 1) ? 0.f : -1.0e30f;
    const unsigned lutb = (unsigned)(uintptr_t)(lds + L_LUT);
    const size_t mb = (size_t)b * SEQ;
    const unsigned vb0 = (unsigned)(uintptr_t)(lds + L_V) + ((lane >> 4) & 1) * 32 + (lane & 3) * 8 + (4 * hi + ((lane & 15) >> 2)) * 64;
    for (int ui = 0; ui < 4; ++ui) {
        const int qb = ui == 0 ? sx : (ui == 1 ? 7 - sx : (ui == 2 ? 8 + sx : 15 - sx));
        const int q0 = 256 * qb, qw = q0 + 32 * wid;
        const bf16* Qw = Qg + (mb + qw) * 512 + h * 64;
        bf16x8 qr[4];
#pragma unroll
        for (int d0 = 0; d0 < 4; ++d0) qr[d0] = *(const bf16x8*)(Qw + (size_t)r32 * 512 + d0 * 16 + hi * 8);
        f32x16 o0 = {0.f, 0.f, 0.f, 0.f, 0.f, 0.f, 0.f, 0.f, 0.f, 0.f, 0.f, 0.f, 0.f, 0.f, 0.f, 0.f}, o1 = o0, osum = o0;
        const int NT = 4 * qb + 4, ktw = (qw + 31) >> 6;
        const bf16* ksrc = Kg + (mb + lane) * 512 + h * 64 + wid * 8;
        const bf16* vsrc = Vg + (mb + 16 * (wid & 3) + (lane >> 2)) * 512 + h * 64 + (wid >> 2) * 32 + (lane & 3) * 8;
        const unsigned long long* msrc = MASK + (size_t)(b * 64) * SEQ + qw + r32;
#define ATT_DMA(t_, b_) { const bf16* kp_ = ksrc + (size_t)(t_) * 64 * 512; const bf16* vp_ = vsrc + (size_t)(t_) * 64 * 512; \
            const unsigned kl_ = (unsigned)(uintptr_t)(lds + L_K + (b_) * 8192) + wid * 1024, vl_ = (unsigned)(uintptr_t)(lds + L_V + (b_) * 8192) + wid * 1024; \
            asm volatile("s_mov_b32 m0, %0\n\tglobal_load_lds_dwordx4 %1, off\n\ts_mov_b32 m0, %2\n\tglobal_load_lds_dwordx4 %3, off" \
                         :: "s"(kl_), "v"(kp_), "s"(vl_), "v"(vp_) : "memory", "m0"); }
        unsigned long long mw = msrc[0];
        ATT_BAR();
        ATT_DMA(0, 0) ATT_DMA(1, 1)
        asm volatile("s_waitcnt vmcnt(2)" ::: "memory");
        int bc = 0;
        for (int kt = 0; kt < NT; ++kt) {
            const int bo = bc * 8192, b2 = bc == 0 ? 2 : bc - 1;
            ATT_BAR();
            unsigned al = ((unsigned)mw >> (4 * hi) & 0x0F0F0F0Fu) << 4, ah = ((unsigned)(mw >> 32) >> (4 * hi) & 0x0F0F0F0Fu) << 4;
            asm volatile("" : "+v"(al), "+v"(ah));
            { const int t2 = kt + 2 < NT ? kt + 2 : NT - 1; ATT_DMA(t2, b2) }
            const unsigned long long mwn = msrc[(size_t)(kt + 1 < 64 ? kt + 1 : 63) * SEQ];
            if (kt <= ktw) {
                f32x16 p0, p1;
                {
#pragma unroll
                  for (int g4 = 0; g4 < 4; ++g4) {
                      const f32x4 t0 = *(const LAS f32x4*)(uintptr_t)(lutb + ((al >> (8 * g4)) & 0xFFu)), t1 = *(const LAS f32x4*)(uintptr_t)(lutb + ((ah >> (8 * g4)) & 0xFFu));
                      p0[4 * g4] = t0[0]; p0[4 * g4 + 1] = t0[1]; p0[4 * g4 + 2] = t0[2]; p0[4 * g4 + 3] = t0[3];
                      p1[4 * g4] = t1[0]; p1[4 * g4 + 1] = t1[1]; p1[4 * g4 + 2] = t1[2]; p1[4 * g4 + 3] = t1[3]; } }
                const LAS unsigned char* kb = lds + L_K + bo + hi * 1024 + r32 * 16;
#pragma unroll
                for (int d0 = 0; d0 < 4; ++d0) { const bf16x8 b0 = *(const LAS bf16x8*)(kb + d0 * 2048), b1 = *(const LAS bf16x8*)(kb + d0 * 2048 + 512);
                    p0 = __builtin_amdgcn_mfma_f32_32x32x16_bf16(b0, qr[d0], p0, 0, 0, 0); p1 = __builtin_amdgcn_mfma_f32_32x32x16_bf16(b1, qr[d0], p1, 0, 0, 0); }
                if (64 * kt + 63 + 112 >= qw) {
                    const LAS float* bt = btab + 128 + (qw + r32 - 64 * kt - 4 * hi);
#pragma unroll
                    for (int r = 0; r < 16; ++r) { const int c = (r & 3) + 8 * (r >> 2); p0[r] += bt[-c]; p1[r] += bt[-c - 32]; }
                }
#pragma unroll
                for (int r = 0; r < 16; ++r) { p0[r] = __builtin_amdgcn_exp2f(p0[r]); p1[r] = __builtin_amdgcn_exp2f(p1[r]); }
                u32x4 pw0, pw1, pw2, pw3;
                pw0 = (u32x4){cvtpk(p0[0], p0[1]), cvtpk(p0[2], p0[3]), cvtpk(p0[4], p0[5]), cvtpk(p0[6], p0[7])};
                pw1 = (u32x4){cvtpk(p0[8], p0[9]), cvtpk(p0[10], p0[11]), cvtpk(p0[12], p0[13]), cvtpk(p0[14], p0[15])};
                pw2 = (u32x4){cvtpk(p1[0], p1[1]), cvtpk(p1[2], p1[3]), cvtpk(p1[4], p1[5]), cvtpk(p1[6], p1[7])};
                pw3 = (u32x4){cvtpk(p1[8], p1[9]), cvtpk(p1[10], p1[11]), cvtpk(p1[12], p1[13]), cvtpk(p1[14], p1[15])};
                const bf16x8 pa0 = __builtin_bit_cast(bf16x8, pw0), pa1 = __builtin_bit_cast(bf16x8, pw1), pa2 = __builtin_bit_cast(bf16x8, pw2), pa3 = __builtin_bit_cast(bf16x8, pw3);
                { const bf16x8 ones = {(short)0x3F80, (short)0x3F80, (short)0x3F80, (short)0x3F80, (short)0x3F80, (short)0x3F80, (short)0x3F80, (short)0x3F80};
                  osum = __builtin_amdgcn_mfma_f32_32x32x16_bf16(pa0, ones, osum, 0, 0, 0); osum = __builtin_amdgcn_mfma_f32_32x32x16_bf16(pa1, ones, osum, 0, 0, 0);
                  osum = __builtin_amdgcn_mfma_f32_32x32x16_bf16(pa2, ones, osum, 0, 0, 0); osum = __builtin_amdgcn_mfma_f32_32x32x16_bf16(pa3, ones, osum, 0, 0, 0); }
                const unsigned vb = vb0 + bo;
#pragma unroll
                for (int d0 = 0; d0 < 2; ++d0) { s16x4 lo[4], hv[4];
#pragma unroll
                    for (int ks = 0; ks < 4; ++ks) {
                        asm volatile("ds_read_b64_tr_b16 %0,%1 offset:%c2" : "=&v"(lo[ks]) : "v"(vb), "i"(d0 * 4096 + ks * 1024) : "memory");
                        asm volatile("ds_read_b64_tr_b16 %0,%1 offset:%c2" : "=&v"(hv[ks]) : "v"(vb), "i"(d0 * 4096 + ks * 1024 + 512) : "memory"); }
                    asm volatile("s_waitcnt lgkmcnt(0)" ::: "memory"); __builtin_amdgcn_sched_barrier(0);
#define PKV(k) (bf16x8){lo[k][0], lo[k][1], lo[k][2], lo[k][3], hv[k][0], hv[k][1], hv[k][2], hv[k][3]}
                    f32x16 oo = d0 == 0 ? o0 : o1;
                    oo = __builtin_amdgcn_mfma_f32_32x32x16_bf16(pa0, PKV(0), oo, 0, 0, 0); oo = __builtin_amdgcn_mfma_f32_32x32x16_bf16(pa1, PKV(1), oo, 0, 0, 0);
                    oo = __builtin_amdgcn_mfma_f32_32x32x16_bf16(pa2, PKV(2), oo, 0, 0, 0); oo = __builtin_amdgcn_mfma_f32_32x32x16_bf16(pa3, PKV(3), oo, 0, 0, 0);
                    if (d0 == 0) o0 = oo; else o1 = oo;
#undef PKV
                }
            }
            mw = mwn; bc = bc == 2 ? 0 : bc + 1;
            asm volatile("s_waitcnt vmcnt(3)" ::: "memory");
        }
        asm volatile("s_waitcnt vmcnt(0)" ::: "memory");
        float rli[16];
#pragma unroll
        for (int r = 0; r < 16; ++r) rli[r] = __builtin_amdgcn_rcpf(osum[r]);
        bf16* Ow = Og + (mb + qw) * 1024 + h * 64;
        LAS bf16* stg = (LAS bf16*)(lds + L_OST) + wid * 2048;
#pragma unroll
        for (int r = 0; r < 16; ++r) { const int orow = crow(r, hi); stg[orow * 64 + r32] = (bf16)f2bf(o0[r] * rli[r]); stg[orow * 64 + 32 + r32] = (bf16)f2bf(o1[r] * rli[r]); }
        asm volatile("s_waitcnt lgkmcnt(0)" ::: "memory");
#pragma unroll
        for (int i = 0; i < 4; ++i) { const int row = i * 8 + (lane >> 3), ch = lane & 7; const u32x4 v = *(const LAS u32x4*)(stg + row * 64 + ch * 8); *(u32x4*)(Ow + (size_t)row * 1024 + ch * 8) = v; }
        asm volatile("s_waitcnt lgkmcnt(0)" ::: "memory");
    }
    __syncthreads();
#undef ATT_BAR
#undef ATT_DMA
}
namespace rc {
constexpr int PB = 72;
constexpr int MB = 64 * PB * 2;
constexpr int O_KG = 0, O_RG = MB, O_BN = 2 * MB, O_KN = 3 * MB;
constexpr int O_BET = 4 * MB, O_KET = 5 * MB, O_VT = 6 * MB;
constexpr int O_AKK = 7 * MB, O_ARB = 8 * MB, O_ARK = 9 * MB;
constexpr int O_WT = 10 * MB, O_UT = 11 * MB;
constexpr int O_AKB = 12 * MB;
constexpr int PF2 = 65;
constexpr int O_F1 = 13 * MB;
constexpr int O_F2 = O_F1 + 64 * 16 * 4;
constexpr int O_G63 = O_F2 + 64 * PF2 * 4;
constexpr int O_TI = O_G63 + 512;
constexpr int O_RT = O_TI + 4 * 16 * 64;
constexpr int O_PAR = O_RT + 2 * 64 * 64;
constexpr int O_END = O_PAR + 8 * 208;
static_assert(O_END <= LDS_BYTES - 512, "RC1 LDS map");
typedef float f32x4v __attribute__((ext_vector_type(4)));
__device__ __forceinline__ f32x4v mma(bf16x8 a, bf16x8 b, f32x4v c) { return __builtin_amdgcn_mfma_f32_16x16x32_bf16(a, b, c, 0, 0, 0); }
__device__ __forceinline__ f32x4v tile(const LAS unsigned char* A, const LAS unsigned char* Bt, int rt, int ct, int fr, int fq, f32x4v acc) {
    const LAS unsigned char* pa = A + ((16 * rt + fr) * PB + 8 * fq) * 2; const LAS unsigned char* pb = Bt + ((16 * ct + fr) * PB + 8 * fq) * 2;
    acc = mma(*(const LAS bf16x8*)pa, *(const LAS bf16x8*)pb, acc);
    acc = mma(*(const LAS bf16x8*)(pa + 64), *(const LAS bf16x8*)(pb + 64), acc);
    return acc;
}
template <bool SA, bool SB> __device__ __forceinline__ f32x4v tileS(const LAS unsigned char* A, const LAS unsigned char* Bt, int rt, int ct, int fr, int fq, f32x4v acc) {
    const int ra = 16 * rt + fr, rb = 16 * ct + fr; const int sa = SA ? ((ra >> 3) & 7) : 0, sb = SB ? ((rb >> 3) & 7) : 0;
    const LAS unsigned char* pa = A + ra * PB * 2; const LAS unsigned char* pb = Bt + rb * PB * 2;
    acc = mma(*(const LAS bf16x8*)(pa + ((fq ^ sa) << 4)), *(const LAS bf16x8*)(pb + ((fq ^ sb) << 4)), acc);
    acc = mma(*(const LAS bf16x8*)(pa + (((fq + 4) ^ sa) << 4)), *(const LAS bf16x8*)(pb + (((fq + 4) ^ sb) << 4)), acc);
    return acc;
}
}
__device__ __forceinline__ void phase_rc1(const Frame& F) {
    using namespace rc;
    const bf16* Z = (const bf16*)(F.ws + WS_Z); const bf16* AA = (const bf16*)(F.ws + WS_AA); bf16* BVg = (bf16*)(F.ws + WS_BV);
    const float* LD = (const float*)(F.ws + WS_XN); bf16* RWg = (bf16*)(F.ws + WS_RW); bf16* Y0g = (bf16*)(F.ws + WS_Y0); bf16* Pg = (bf16*)(F.ws + WS_P); bf16* QTg = (bf16*)(F.ws + WS_QT);
    LAS unsigned char* L = F.lds; LAS float* F1 = (LAS float*)(L + O_F1); LAS float* F2 = (LAS float*)(L + O_F2); LAS float* G63 = (LAS float*)(L + O_G63);
    const int tid = F.tid, lane = F.lane, wave = F.wave, fr = lane & 15, fq = lane >> 4;
    const int t = tid >> 3, c8 = tid & 7;
    __syncthreads();
    for (int i = tid; i < (4 * 16 * 64 + 2 * 64 * 64) / 16; i += 512) *(LAS u32x4*)(L + O_TI + 16 * i) = (u32x4){0u, 0u, 0u, 0u};
    if (tid < 384) { const int hh_ = (F.vcu >> 2) & 7, c8_ = tid / 48, k_ = tid % 48, vec = k_ >> 3, e_ = k_ & 7;
        const float* src = vec < 3 ? F.in[6] + 512 * vec : (vec == 3 ? F.in[12] : (vec == 4 ? F.in[13] : F.in[14]));
        *(LAS float*)(L + O_PAR + c8_ * 208 + k_ * 4) = src[hh_ * 64 + 8 * c8_ + e_]; }
    const int bh = F.vcu >> 2, b = bh >> 3, h = bh & 7;
    struct RcIn { f32x4 t0, t1; };
#define RC_LOADIN(x_, ch_) { const size_t mr_ = (size_t)b * SEQ + 64 * (ch_) + t; \
        const float* ts_ = LD + ((size_t)b * SEQ + 64 * (ch_) + lane) * 512 + h * 64 + 8 * wave; x_.t0 = *(const f32x4*)ts_; x_.t1 = *(const f32x4*)(ts_ + 4); }
    RcIn cur, nxt; RC_LOADIN(cur, (F.vcu & 3))
    for (int j = 0; j < 16; ++j) {
        const int ch = (F.vcu & 3) + 4 * j, u = bh * 64 + ch; const size_t m0 = (size_t)b * SEQ + 64 * ch;
        bf16* rwu = RWg + (size_t)u * 4096; bf16* y0u = Y0g + (size_t)u * 4096; bf16* pu = Pg + (size_t)u * 4096; bf16* qtu = QTg + (size_t)u * 4096;
        const size_t mrow = m0 + t;
        const bf16* zrow = Z + mrow * RWW + h * 64 + 8 * c8;
        const u32x4 wr_ = *(const u32x4*)(zrow), wk_ = *(const u32x4*)(zrow + 512), wv_ = *(const u32x4*)(zrow + 1024);
        u32x4 pr_ = (u32x4){0u, 0u, 0u, 0u}, pk_ = pr_, pv_ = pr_;
        if ((ch | t) != 0) { pr_ = *(const u32x4*)(zrow - RWW); pk_ = *(const u32x4*)(zrow - RWW + 512); pv_ = *(const u32x4*)(zrow - RWW + 1024); }
        const u32x4 wa_ = *(const u32x4*)(AA + mrow * 512 + h * 64 + 8 * c8);
        LAS float* G63p = G63 + (j & 1) * 64;
        { float xs[8] = {cur.t0[0], cur.t0[1], cur.t0[2], cur.t0[3], cur.t1[0], cur.t1[1], cur.t1[2], cur.t1[3]};
#pragma unroll
          for (int i = 0; i < 8; ++i) { float x = xs[i];
#define RC_SCAN(ctrl, rm) x += __builtin_bit_cast(float, __builtin_amdgcn_update_dpp(0, __builtin_bit_cast(int, x), ctrl, rm, 0xf, false))
              RC_SCAN(0x111, 0xf); RC_SCAN(0x112, 0xf); RC_SCAN(0x114, 0xf); RC_SCAN(0x118, 0xf); RC_SCAN(0x142, 0xa); RC_SCAN(0x143, 0xc);
#undef RC_SCAN
              F2[lane * PF2 + 8 * wave + i] = x; if (lane == 63) G63p[8 * wave + i] = x; } }
        __syncthreads();
        float mur[8], muk[8], muv_[8], kkw[8], kaw[8], rkw[8];
        { const LAS f32x4* pp_ = (const LAS f32x4*)(L + O_PAR + c8 * 208);
#define RC_LDP(dst, k_) { const f32x4 a_ = pp_[2 * (k_)], b_ = pp_[2 * (k_) + 1]; dst[0] = a_[0]; dst[1] = a_[1]; dst[2] = a_[2]; dst[3] = a_[3]; dst[4] = b_[0]; dst[5] = b_[1]; dst[6] = b_[2]; dst[7] = b_[3]; }
          RC_LDP(mur, 0) RC_LDP(muk, 1) RC_LDP(muv_, 2) RC_LDP(kkw, 3) RC_LDP(kaw, 4) RC_LDP(rkw, 5)
#undef RC_LDP
        }
        { float r[8], k[8], v[8], kk[8], bb[8], aa[8]; unpack8(wr_, r); unpack8(wk_, k); unpack8(wv_, v); unpack8(wa_, aa);
          { float q_[8];
            unpack8(pr_, q_);
#pragma unroll
            for (int i = 0; i < 8; ++i) r[i] = r[i] + mur[i] * (q_[i] - r[i]);
            unpack8(pk_, q_);
#pragma unroll
            for (int i = 0; i < 8; ++i) k[i] = k[i] + muk[i] * (q_[i] - k[i]);
            unpack8(pv_, q_);
#pragma unroll
            for (int i = 0; i < 8; ++i) v[i] = v[i] + muv_[i] * (q_[i] - v[i]); }
          { float ss = 0.f;
#pragma unroll
            for (int i = 0; i < 8; ++i) { kk[i] = k[i] * kkw[i]; ss += kk[i] * kk[i]; }
            ss = sum8(ss); const float inv = 1.0f / fmaxf(sqrtf(ss), 1e-12f);
#pragma unroll
            for (int i = 0; i < 8; ++i) { kk[i] *= inv; bb[i] = kk[i] * aa[i]; k[i] = k[i] * (1.0f + (aa[i] - 1.0f) * kaw[i]); } }
          { float dt = 0.f;
#pragma unroll
            for (int i = 0; i < 8; ++i) dt += r[i] * k[i] * rkw[i];
            dt = sum8(dt); float bv[8];
#pragma unroll
            for (int i = 0; i < 8; ++i) bv[i] = dt * v[i];
            *(u32x4*)(BVg + mrow * 512 + h * 64 + 8 * c8) = pack8(bv); }
          float kg[8], rg[8], bn[8], kn[8], be[8], ke[8];
#pragma unroll
          for (int i = 0; i < 8; ++i) { const float g = F2[t * PF2 + 8 * c8 + i], g63 = G63p[8 * c8 + i], gp = t > 0 ? F2[(t - 1) * PF2 + 8 * c8 + i] : 0.f;
              const float eg = __expf(g), egp = __expf(gp), en = __expf(-g), ee = __expf(g63 - g);
              kg[i] = kk[i] * egp; rg[i] = r[i] * eg; bn[i] = bb[i] * en; kn[i] = k[i] * en; be[i] = bb[i] * ee; ke[i] = k[i] * ee; }
          const int ro = (t * PB + 8 * c8) * 2;
          *(LAS u32x4*)(L + O_KG + ro) = pack8(kg); *(LAS u32x4*)(L + O_RG + ro) = pack8(rg); *(LAS u32x4*)(L + O_BN + ro) = pack8(bn); *(LAS u32x4*)(L + O_KN + ro) = pack8(kn);
#pragma unroll
          for (int i = 0; i < 8; ++i) { const int to = ((8 * c8 + i) * PB + ((((t >> 3) ^ c8) << 3) | (t & 7))) * 2;
              *(LAS bf16*)(L + O_BET + to) = (bf16)f2bf(be[i]); *(LAS bf16*)(L + O_KET + to) = (bf16)f2bf(ke[i]); *(LAS bf16*)(L + O_VT + to) = (bf16)f2bf(v[i]); } }
        for (int i = tid; i < 2 * MB / 16; i += 512) *(LAS u32x4*)(L + O_WT + 16 * i) = (u32x4){0u, 0u, 0u, 0u};
        __syncthreads();
        { const int rt = wave & 3; const bool isR = wave >= 4; const LAS unsigned char* Am = L + (isR ? O_RG : O_KG);
#pragma unroll
          for (int ct8 = 0; ct8 < 8; ++ct8) { const int ct = ct8 & 3; const bool isK = ct8 >= 4;
              f32x4v acc = {0.f, 0.f, 0.f, 0.f}; acc = tile(Am, L + (isK ? O_KN : O_BN), rt, ct, fr, fq, acc);
              const int j = 16 * ct + fr;
#pragma unroll
              for (int i = 0; i < 4; ++i) { const int tt = 16 * rt + 4 * fq + i; const bool keep = isR ? (j <= tt) : (j < tt); const float val = keep ? acc[i] : 0.f;
                  if (!isR && !isK && rt == ct) F1[tt * 16 + (j & 15)] = val;
                  *(LAS bf16*)(L + (isR ? (isK ? O_ARK : O_ARB) : (isK ? O_AKK : O_AKB)) + (tt * PB + j) * 2) = (bf16)f2bf(val); } } }
        __syncthreads();
        { const int rt = wave >> 1;
#pragma unroll
          for (int cc = 0; cc < 2; ++cc) { const int ct = 2 * (wave & 1) + cc; f32x4v acc = {0.f, 0.f, 0.f, 0.f}; acc = tileS<false, true>(L + O_AKK, L + O_VT, rt, ct, fr, fq, acc);
#pragma unroll
              for (int i = 0; i < 4; ++i) F2[(16 * rt + 4 * fq + i) * PF2 + 16 * ct + fr] = acc[i]; } }
        if (wave >= 2 && wave < 6) {
            const int blk = wave - 2, cidx = lane & 15; const LAS float* cb = F1 + blk * 256; asm volatile("" : "+v"(cb));
            float x[16]; f32x4 ce[4], co[4];
#define RC_FETCH(i_, C_) { _Pragma("unroll") for (int j4 = 0; j4 < ((i_) + 3) / 4; ++j4) C_[j4] = *(volatile const LAS f32x4*)(cb + (i_) * 16 + 4 * j4); }
#define RC_SOLVE(i_, C_) { float acc_ = (cidx == (i_)) ? 1.0f : 0.0f; \
                _Pragma("unroll") for (int j4 = 0; j4 < ((i_) + 3) / 4; ++j4) { _Pragma("unroll") for (int e = 0; e < 4; ++e) if (4 * j4 + e < (i_)) acc_ -= C_[j4][e] * x[4 * j4 + e]; } \
                asm volatile("" : "+v"(acc_)); x[i_] = acc_; }
#define RC_ROW2(i_) { RC_FETCH((i_) + 1, co) RC_SOLVE((i_), ce) if ((i_) + 2 < 16) RC_FETCH((i_) + 2, ce) RC_SOLVE((i_) + 1, co) }
            RC_FETCH(0, ce)
            RC_ROW2(0) RC_ROW2(2) RC_ROW2(4) RC_ROW2(6) RC_ROW2(8) RC_ROW2(10) RC_ROW2(12) RC_ROW2(14)
#undef RC_ROW2
#undef RC_SOLVE
#undef RC_FETCH
            if (lane < 16) {
#pragma unroll
                for (int i = 0; i < 16; ++i) *(LAS bf16*)(L + O_TI + ((blk * 16 + i) * 32 + cidx) * 2) = (bf16)f2bf(x[i]); }
        }
        __syncthreads();
        {
            const int mat = wave >> 2, ct = wave & 3;
            LAS unsigned char* XT = L + (mat == 0 ? O_WT : O_UT); LAS unsigned char* RT = L + O_RT + mat * 4096;
            const int c = 16 * ct + fr;
#pragma unroll 1
            for (int blk = 0; blk < 4; ++blk) {
                { f32x4v acc = {0.f, 0.f, 0.f, 0.f}; acc = tile(L + O_AKB, XT, blk, ct, fr, fq, acc);
                    const int t0 = 16 * blk + 4 * fq; float rv[4];
                    if (mat == 0) {
#pragma unroll
                        for (int i = 0; i < 4; ++i) rv[i] = bflo((unsigned)*(const LAS bf16*)(L + O_KG + ((t0 + i) * PB + c) * 2));
                    } else {
#pragma unroll
                        for (int i = 0; i < 4; ++i) rv[i] = F2[(t0 + i) * PF2 + c]; }
                    u32x2 w; w.x = pk2(rv[0] - acc[0], rv[1] - acc[1]); w.y = pk2(rv[2] - acc[2], rv[3] - acc[3]);
                    *(LAS u32x2*)(RT + (c * 32 + 4 * fq) * 2) = w; }
                asm volatile("s_waitcnt lgkmcnt(0)" ::: "memory");
                const bf16x8 ta = *(const LAS bf16x8*)(L + O_TI + ((blk * 16 + fr) * 32 + 8 * fq) * 2);
                { f32x4v acc = {0.f, 0.f, 0.f, 0.f};
                    acc = mma(ta, *(const LAS bf16x8*)(RT + (c * 32 + 8 * fq) * 2), acc);
                    u32x2 w; w.x = pk2(acc[0], acc[1]); w.y = pk2(acc[2], acc[3]);
                    *(LAS u32x2*)(XT + (c * PB + 16 * blk + 4 * fq) * 2) = w; }
                asm volatile("s_waitcnt lgkmcnt(0)" ::: "memory");
            }
        }
        __syncthreads();
        if (j + 1 < 16) RC_LOADIN(nxt, ch + 4)
        { const int mtx = wave >> 1, hf = wave & 1; bf16* outp = mtx == 0 ? rwu : (mtx == 1 ? y0u : (mtx == 2 ? pu : qtu));
#pragma unroll 1
          for (int rr = 0; rr < 2; ++rr) { const int rt = 2 * hf + rr;
#pragma unroll 1
              for (int ct2 = 0; ct2 < 4; ct2 += 2) { u32x2 wp[2];
#pragma unroll
                for (int e2 = 0; e2 < 2; ++e2) { const int ct = ct2 + e2;
                  const int col = 16 * ct + fr, row0 = 16 * rt + 4 * fq;
                  f32x4v acc = {0.f, 0.f, 0.f, 0.f}; u32x2 w;
                  if (mtx == 0) {
                      acc = tile(L + O_WT, L + O_ARB, rt, ct, fr, fq, acc);
                      const unsigned long long rgw = *(const LAS unsigned long long*)(L + O_RG + (col * PB + row0) * 2);
                      const float o0 = bflo((unsigned)rgw) - acc[0], o1 = bfhi((unsigned)rgw) - acc[1], o2 = bflo((unsigned)(rgw >> 32)) - acc[2], o3 = bfhi((unsigned)(rgw >> 32)) - acc[3];
                      w.x = pk2(o0, o1); w.y = pk2(o2, o3);
                  } else if (mtx == 1) {
                      acc = tileS<true, false>(L + O_VT, L + O_ARK, rt, ct, fr, fq, acc); f32x4v a2 = {0.f, 0.f, 0.f, 0.f}; a2 = tile(L + O_UT, L + O_ARB, rt, ct, fr, fq, a2);
                      w.x = pk2(acc[0] - a2[0], acc[1] - a2[1]); w.y = pk2(acc[2] - a2[2], acc[3] - a2[3]);
                  } else if (mtx == 2) {
                      acc = tileS<false, true>(L + O_WT, L + O_BET, rt, ct, fr, fq, acc); const float dg = __expf(G63p[col]);
                      const float o0 = (row0 + 0 == col ? dg : 0.f) - acc[0], o1 = (row0 + 1 == col ? dg : 0.f) - acc[1], o2 = (row0 + 2 == col ? dg : 0.f) - acc[2], o3 = (row0 + 3 == col ? dg : 0.f) - acc[3];
                      w.x = pk2(o0, o1); w.y = pk2(o2, o3);
                  } else {
                      acc = tileS<true, true>(L + O_KET, L + O_VT, rt, ct, fr, fq, acc); f32x4v a2 = {0.f, 0.f, 0.f, 0.f}; a2 = tileS<true, false>(L + O_BET, L + O_UT, rt, ct, fr, fq, a2);
                      w.x = pk2(acc[0] - a2[0], acc[1] - a2[1]); w.y = pk2(acc[2] - a2[2], acc[3] - a2[3]);
                  }
                  wp[e2] = w; }
                { const auto rx = __builtin_amdgcn_permlane16_swap(wp[0].x, wp[1].x, false, false), ry = __builtin_amdgcn_permlane16_swap(wp[0].y, wp[1].y, false, false);
                  const int colS = 16 * (ct2 + (fq & 1)) + fr, rowS = 16 * rt + 4 * (fq & ~1);
                  *(u32x4*)(outp + colS * 64 + rowS) = (u32x4){rx[0], ry[0], rx[1], ry[1]}; }
              } } }
        if (j + 1 < 16) cur = nxt;
    }
#undef RC_LOADIN
    __syncthreads();
}
__device__ __forceinline__ void phase_rc2(const Frame& F) {
    using namespace rc;
    const bf16* Pg = (const bf16*)(F.ws + WS_P); const bf16* QTg = (const bf16*)(F.ws + WS_QT); bf16* SC = (bf16*)(F.ws + WS_SC);
    const int lane = F.lane, wave = F.wave, fr = lane & 15, fq = lane >> 4;
    __syncthreads();
    if (wave == 0) {
        const int bh = F.vcu >> 2, vt = F.vcu & 3; const size_t u0 = (size_t)bh * 64;
        LAS unsigned char* Lw = F.lds;
        f32x4v S[4];
#pragma unroll
        for (int rt = 0; rt < 4; ++rt) S[rt] = (f32x4v){0.f, 0.f, 0.f, 0.f};
        const bf16* pp = Pg + u0 * 4096 + fr * 64 + 8 * fq;
        const bf16* pq = QTg + u0 * 4096 + (16 * vt + fr) * 64 + 4 * fq;
        bf16x8 pr[3][4][2]; u32x2 qr[3][4];
#define RC2_LOAD(slot, c_) do { _Pragma("unroll") for (int rt = 0; rt < 4; ++rt) { _Pragma("unroll") for (int ks = 0; ks < 2; ++ks) pr[slot][rt][ks] = *(const bf16x8*)(pp + (size_t)(c_) * 4096 + rt * 1024 + 32 * ks); \
            qr[slot][rt] = *(const u32x2*)(pq + (size_t)(c_) * 4096 + 16 * rt); } } while (0)
#define RC2_STEP(slot, c_) do { if ((c_) < 64) { bf16* sc = SC + (u0 + (c_)) * 4096 + (16 * vt + fr) * 64 + 4 * fq; \
            _Pragma("unroll") for (int rt = 0; rt < 4; ++rt) { u32x2 w; w.x = pk2(S[rt][0], S[rt][1]); w.y = pk2(S[rt][2], S[rt][3]); \
                *(u32x2*)(sc + 16 * rt) = w; *(LAS u32x2*)(Lw + (fr * PB + 16 * rt + 4 * fq) * 2) = w; } \
            asm volatile("s_waitcnt lgkmcnt(0)" ::: "memory"); \
            const bf16x8 b0 = *(const LAS bf16x8*)(Lw + (fr * PB + 8 * fq) * 2), b1 = *(const LAS bf16x8*)(Lw + (fr * PB + 32 + 8 * fq) * 2); \
            _Pragma("unroll") for (int rt = 0; rt < 4; ++rt) { f32x4v acc = {bflo(qr[slot][rt].x), bfhi(qr[slot][rt].x), bflo(qr[slot][rt].y), bfhi(qr[slot][rt].y)}; \
                acc = mma(pr[slot][rt][0], b0, acc); acc = mma(pr[slot][rt][1], b1, acc); S[rt] = acc; } \
            asm volatile("s_waitcnt lgkmcnt(0)" ::: "memory"); \
            if ((c_) + 3 < 64) RC2_LOAD(slot, (c_) + 3); } } while (0)
        RC2_LOAD(0, 0); RC2_LOAD(1, 1); RC2_LOAD(2, 2);
#pragma unroll 1
        for (int c = 0; c < 66; c += 3) { RC2_STEP(0, c); RC2_STEP(1, c + 1); RC2_STEP(2, c + 2); }
#undef RC2_LOAD
#undef RC2_STEP
    }
    __syncthreads();
}
__device__ __forceinline__ void phase_rc3(const Frame& F) {
    using namespace rc;
    const bf16* RWg = (const bf16*)(F.ws + WS_RW); const bf16* Y0g = (const bf16*)(F.ws + WS_Y0); const bf16* SC = (const bf16*)(F.ws + WS_SC); bf16* Y = (bf16*)(F.ws + WS_Y);
    const int lane = F.lane, fr = lane & 15, fq = lane >> 4;
    const int gw = F.vcu * 8 + F.wave, NGW = F.G * 8;
    for (int it = gw; it < 4096 * 4; it += NGW) {
        const int u = it >> 2, rt = it & 3, bh = u >> 6, ch = u & 63, b = bh >> 3, h = bh & 7;
        const bf16* rwu = RWg + (size_t)u * 4096; const bf16* y0u = Y0g + (size_t)u * 4096; const bf16* sc = SC + (size_t)u * 4096;
        bf16x8 a[2];
#pragma unroll
        for (int ks = 0; ks < 2; ++ks) a[ks] = *(const bf16x8*)(sc + (16 * rt + fr) * 64 + 32 * ks + 8 * fq);
#pragma unroll
        for (int ct = 0; ct < 4; ++ct) { const int tt = 16 * ct + fr, v0 = 16 * rt + 4 * fq;
            const u32x2 y0w = *(const u32x2*)(y0u + tt * 64 + v0); f32x4v acc = {bflo(y0w.x), bfhi(y0w.x), bflo(y0w.y), bfhi(y0w.y)};
#pragma unroll
            for (int ks = 0; ks < 2; ++ks) acc = mma(a[ks], *(const bf16x8*)(rwu + (16 * ct + fr) * 64 + 32 * ks + 8 * fq), acc);
            u32x2 w; w.x = pk2(acc[0], acc[1]); w.y = pk2(acc[2], acc[3]);
            *(u32x2*)(Y + ((size_t)b * SEQ + 64 * ch + tt) * 512 + h * 64 + v0) = w; }
    }
}
__device__ __forceinline__ void phase_rc23(const Frame& F) {
    using namespace rc;
    const bf16* Pg = (const bf16*)(F.ws + WS_P); const bf16* QTg = (const bf16*)(F.ws + WS_QT);
    const bf16* RWg = (const bf16*)(F.ws + WS_RW); const bf16* Y0g = (const bf16*)(F.ws + WS_Y0); bf16* Y = (bf16*)(F.ws + WS_Y);
    const int lane = F.lane, wave = F.wave, fr = lane & 15, fq = lane >> 4;
    volatile LAS unsigned* prog = (volatile LAS unsigned*)(F.lds + LDS_BYTES - 512) + 8;
    constexpr int STRIP = 16 * PB * 2;
    __syncthreads();
    if (F.tid == 0) *prog = 0u;
    __syncthreads();
    const int bh = F.vcu >> 2, vt = F.vcu & 3, b = bh >> 3, h = bh & 7; const size_t u0 = (size_t)bh * 64;
    if (wave == 0) {
        f32x4v S[4];
#pragma unroll
        for (int rt = 0; rt < 4; ++rt) S[rt] = (f32x4v){0.f, 0.f, 0.f, 0.f};
        const bf16* pp = Pg + u0 * 4096 + fr * 64 + 8 * fq;
        const bf16* pq = QTg + u0 * 4096 + (16 * vt + fr) * 64 + 4 * fq;
        bf16x8 pr[3][4][2]; u32x2 qr[3][4];
#define RC2_LOAD(slot, c_) do { _Pragma("unroll") for (int rt = 0; rt < 4; ++rt) { _Pragma("unroll") for (int ks = 0; ks < 2; ++ks) pr[slot][rt][ks] = *(const bf16x8*)(pp + (size_t)(c_) * 4096 + rt * 1024 + 32 * ks); \
            qr[slot][rt] = *(const u32x2*)(pq + (size_t)(c_) * 4096 + 16 * rt); } } while (0)
#define RC2_STEP(slot, c_) do { { LAS unsigned char* Lw = F.lds + (c_) * STRIP; \
            _Pragma("unroll") for (int rt = 0; rt < 4; ++rt) { u32x2 w; w.x = pk2(S[rt][0], S[rt][1]); w.y = pk2(S[rt][2], S[rt][3]); \
                *(LAS u32x2*)(Lw + (fr * PB + 16 * rt + 4 * fq) * 2) = w; } \
            asm volatile("s_waitcnt lgkmcnt(0)" ::: "memory"); \
            if (lane == 0) *prog = (unsigned)((c_) + 1);                  \
            const bf16x8 b0 = *(const LAS bf16x8*)(Lw + (fr * PB + 8 * fq) * 2), b1 = *(const LAS bf16x8*)(Lw + (fr * PB + 32 + 8 * fq) * 2); \
            _Pragma("unroll") for (int rt = 0; rt < 4; ++rt) { f32x4v acc = {bflo(qr[slot][rt].x), bfhi(qr[slot][rt].x), bflo(qr[slot][rt].y), bfhi(qr[slot][rt].y)}; \
                acc = mma(pr[slot][rt][0], b0, acc); acc = mma(pr[slot][rt][1], b1, acc); S[rt] = acc; } \
            RC2_LOAD(slot, ((c_) + 3 < 64 ? (c_) + 3 : 63));            \
            } } while (0)
        RC2_LOAD(0, 0); RC2_LOAD(1, 1); RC2_LOAD(2, 2);
#pragma unroll 1
        for (int c = 0; c < 63; c += 3) { RC2_STEP(0, c); RC2_STEP(1, c + 1); RC2_STEP(2, c + 2); }
        RC2_STEP(0, 63);
#undef RC2_LOAD
#undef RC2_STEP
    } else {
#pragma unroll 1
        for (int c = wave - 1; c < 64; c += 7) {
            const size_t u = u0 + c; const bf16* rwu = RWg + u * 4096; const bf16* y0u = Y0g + u * 4096;
            const int vq = 16 * vt + 4 * (fq & ~1), sel = fq & 1;
            bf16x8 bq[4][2]; u32x4 y0l[2];
#pragma unroll
            for (int ct = 0; ct < 4; ++ct) { const int tt = 16 * ct + fr;
#pragma unroll
                for (int ks = 0; ks < 2; ++ks) bq[ct][ks] = *(const bf16x8*)(rwu + tt * 64 + 32 * ks + 8 * fq); }
#pragma unroll
            for (int pr = 0; pr < 2; ++pr) y0l[pr] = *(const u32x4*)(y0u + (16 * (2 * pr + sel) + fr) * 64 + vq);
            while (*prog <= (unsigned)c) __builtin_amdgcn_s_sleep(2);
            const LAS unsigned char* Lw = F.lds + c * STRIP;
            const bf16x8 a0 = *(const LAS bf16x8*)(Lw + (fr * PB + 8 * fq) * 2), a1 = *(const LAS bf16x8*)(Lw + (fr * PB + 32 + 8 * fq) * 2);
#pragma unroll
            for (int pr = 0; pr < 2; ++pr) {
                const auto lx = __builtin_amdgcn_permlane16_swap(y0l[pr].x, y0l[pr].z, false, false), ly = __builtin_amdgcn_permlane16_swap(y0l[pr].y, y0l[pr].w, false, false);
                u32x2 wp[2];
#pragma unroll
                for (int e2 = 0; e2 < 2; ++e2) { const int ct = 2 * pr + e2; const unsigned yx = lx[e2], yy = ly[e2];
                    f32x4v acc = {bflo(yx), bfhi(yx), bflo(yy), bfhi(yy)};
                    acc = mma(a0, bq[ct][0], acc); acc = mma(a1, bq[ct][1], acc);
                    wp[e2].x = pk2(acc[0], acc[1]); wp[e2].y = pk2(acc[2], acc[3]); }
                const auto rx = __builtin_amdgcn_permlane16_swap(wp[0].x, wp[1].x, false, false), ry = __builtin_amdgcn_permlane16_swap(wp[0].y, wp[1].y, false, false);
                *(u32x4*)(Y + ((size_t)b * SEQ + 64 * c + 16 * (2 * pr + sel) + fr) * 512 + h * 64 + vq) = (u32x4){rx[0], ry[0], rx[1], ry[1]}; }
        }
    }
    __syncthreads();
}
constexpr int NPHASE = 14;
constexpr int CW_BAR = 4096;
constexpr int MISC_OFF = LDS_BYTES - 256;
#define RLX_AGENT __ATOMIC_RELAXED, __HIP_MEMORY_SCOPE_AGENT
#define XB_TMO      128
#define XB_XCNT(j)  (256  + 64 * (j))
#define XB_XSUB(j)  (1280 + 64 * (j))
#define XB_XGEN(j)  (2304 + 64 * (j))
#define XB_TOP      3328
#define XB_TOPGEN   3392
#define XCD_BAR_WORDS 3456
#define XB_SPIN_CAP (1u << 18)

__device__ __forceinline__ unsigned xb_ld(unsigned* p)              { return __hip_atomic_load(p, __ATOMIC_RELAXED, __HIP_MEMORY_SCOPE_AGENT); }
__device__ __forceinline__ unsigned xb_add(unsigned* p, unsigned v) { return __hip_atomic_fetch_add(p, v, __ATOMIC_RELAXED, __HIP_MEMORY_SCOPE_AGENT); }
__device__ __forceinline__ unsigned xb_xcc_id() { return (unsigned)__builtin_amdgcn_s_getreg((3 << 11) | 20) & 0xFu; }
#define XB_SPIN(cond, bar) do { unsigned _sp = 0; while (cond) { __builtin_amdgcn_s_sleep(1); \
    if ((++_sp & 255u) == 0u) { if (xb_ld(&(bar)[XB_TMO])) break; if (_sp > XB_SPIN_CAP) { atomicAdd(&(bar)[XB_TMO], 1u); break; } } } } while (0)

struct XcdBarrier {
    unsigned* bar; unsigned x;
    volatile LAS unsigned* st;
};

__device__ __forceinline__ XcdBarrier xcd_barrier_post(unsigned* bar, volatile LAS unsigned* st) {
    XcdBarrier b; b.bar = bar; b.x = xb_xcc_id(); b.st = st;
    if (threadIdx.x == 0) (void)xb_add(&bar[XB_XCNT(b.x)], 1u);
    return b;
}
__device__ __forceinline__ void xcd_barrier_complete(unsigned* bar, unsigned x, unsigned& nloc, unsigned& nx) {
    const unsigned G = gridDim.x * gridDim.y * gridDim.z;
    unsigned sum, cnt, mine, sp = 0u;
    for (;;) {
        sum = 0u; cnt = 0u; mine = 0u;
#pragma unroll
        for (unsigned j = 0; j < 16; ++j) { const unsigned c = xb_ld(&bar[XB_XCNT(j)]); sum += c; cnt += (c > 0u) ? 1u : 0u; mine = (j == x) ? c : mine; }
        if (sum == G) break;
        __builtin_amdgcn_s_sleep(1);
        if ((++sp & 255u) == 0u) { if (xb_ld(&bar[XB_TMO])) break; if (sp > XB_SPIN_CAP) { atomicAdd(&bar[XB_TMO], 1u); break; } }
    }
    nloc = mine > 0u ? mine : 1u; nx = cnt > 0u ? cnt : 1u;
}

__device__ __forceinline__ void xcd_barrier(const XcdBarrier& b) {
    asm volatile("s_waitcnt vmcnt(0)" ::: "memory");
    __syncthreads();
    if (threadIdx.x == 0) {
        unsigned* bar = b.bar;
        __builtin_amdgcn_s_waitcnt(0);
        unsigned nloc = b.st[0], nx = b.st[1];
        if (nloc == 0u) { xcd_barrier_complete(bar, b.x, nloc, nx); b.st[0] = nloc; b.st[1] = nx; }
        const unsigned old = xb_add(&bar[XB_XSUB(b.x)], 1u);
        const unsigned gen = old / nloc;
        if (old + 1u == (gen + 1u) * nloc) {
            __builtin_amdgcn_fence(__ATOMIC_RELEASE, "agent");
            asm volatile("s_waitcnt vmcnt(0)" ::: "memory");
            const unsigned og = xb_add(&bar[XB_TOP], 1u);
            const unsigned tg = og / nx;
            if (og + 1u == (tg + 1u) * nx) xb_add(&bar[XB_TOPGEN], 1u);
            else XB_SPIN(xb_ld(&bar[XB_TOPGEN]) == tg, bar);
            __builtin_amdgcn_fence(__ATOMIC_ACQUIRE, "agent");
            xb_add(&bar[XB_XGEN(b.x)], 1u);
            asm volatile("s_waitcnt vmcnt(0)" ::: "memory");
        } else {
            XB_SPIN(xb_ld(&bar[XB_XGEN(b.x)]) == gen, bar);
            __builtin_amdgcn_fence(__ATOMIC_ACQUIRE, "agent");
            asm volatile("s_waitcnt vmcnt(0)" ::: "memory");
        }
    }
    __syncthreads();
}

template <class Epi> __device__ __forceinline__ void run_gemm(const Frame& F, const bf16* A, const bf16* Bt, int N, int K, const Epi& E) {
    pg8::Gemm g{A, Bt, T, N, K}; pg8::StaticOrder S; S.init(T, N, F.G, (int)blockIdx.x);
    pg8::gemm_phase<Epi, pg8::StaticOrder, true, true>(F.lds, g, S, E);
}
__global__ void __launch_bounds__(512, 2) mega(Args args) {
    extern __shared__ __attribute__((aligned(16))) unsigned char lds_raw[];
    Frame F;
    F.lds = (LAS unsigned char*)lds_raw; F.tid = threadIdx.x; F.lane = F.tid & 63; F.wave = __builtin_amdgcn_readfirstlane(F.tid >> 6);
    F.G = gridDim.x; { const int bx = blockIdx.x; F.vcu = (F.G % 8 == 0) ? (bx % 8) * (F.G / 8) + bx / 8 : bx; }
#pragma unroll
    for (int i = 0; i < 23; ++i) F.in[i] = args.in[i];
    F.out = args.out; F.ws = args.ws;
    unsigned char* ws = args.ws;
    const int lo = args.ph_lo, hi = args.ph_hi;
    for (int u = F.tid; u < 512 / 4; u += 512) ((LAS unsigned*)(F.lds + LDS_BYTES - 512))[u] = 0u;
    __syncthreads();
    XcdBarrier bar = xcd_barrier_post((unsigned*)(ws + WS_CTL) + CW_BAR, (volatile LAS unsigned*)(F.lds + MISC_OFF) + 8);
#define IN(k) (lo <= (k) && (k) < hi)
#define SEAM(k) do { if (IN(k) && IN((k) + 1)) xcd_barrier(bar); } while (0)
    if (IN(0)) phase_p0(F);
    SEAM(0);
    if (IN(1)) { EpiInProj E{(bf16*)(ws + WS_Q), (bf16*)(ws + WS_K), (bf16*)(ws + WS_V), (bf16*)(ws + WS_QI), (bf16*)(ws + WS_KI), (bf16*)(ws + WS_Z), (bf16*)F.out, (float*)(ws + WS_WI), F.in[3], F.in[4]};
        run_gemm(F, (const bf16*)(ws + WS_XN), (const bf16*)(ws + WS_WIN), NPROJ, 1024, E); }
    SEAM(1);
    if (IN(2)) phase_idx(F);
    if (IN(3)) phase_pr1(F);
    SEAM(3);
    if (IN(4)) { const bf16* A12 = (const bf16*)(ws + WS_A12); const bf16* WL = (const bf16*)(ws + WS_WL);
        { EpiLoraAll E{(float*)(ws + WS_XN), (bf16*)(ws + WS_AA), (bf16*)(ws + WS_GG), F.in[7], F.in[9]}; run_gemm(F, A12, WL, 1536, LK, E); } }
    if (IN(6)) phase_attn(F);
    SEAM(6);
    if (IN(7)) { phase_rc1(F); xcd_barrier(bar); phase_rc23(F); }
    SEAM(7);
    if (IN(8)) phase_post(F);
    SEAM(8);
    if (IN(9)) { EpiBranchFused E{(const bf16*)F.out, (bf16*)(ws + WS_MRG)}; run_gemm(F, (const bf16*)(ws + WS_YA2), (const bf16*)(ws + WS_WBA), 1024, 1024, E); }
    SEAM(10);
    if (IN(11)) { EpiOut E{F.in[0], F.out, (bf16*)(ws + WS_XN), (float*)(ws + WS_SSQ)}; run_gemm(F, (const bf16*)(ws + WS_MRG), (const bf16*)(ws + WS_WO), 1024, 1024, E); }
    SEAM(11);
    if (IN(12)) { EpiGateUp E{(const float*)(ws + WS_SSQ), (bf16*)(ws + WS_ACT)}; run_gemm(F, (const bf16*)(ws + WS_XN), (const bf16*)(ws + WS_WGU), 2 * FFH, 1024, E); }
    SEAM(12);
    if (IN(13)) { EpiDown E{F.out, (const bf16*)(ws + WS_XN)}; run_gemm(F, (const bf16*)(ws + WS_ACT), (const bf16*)(ws + WS_WD), 1024, FFH, E); }
#undef IN
}

extern "C" void kernel_launch(void* const* d_in, const int* in_sizes, int n_in, void* d_out, int out_size, void* d_ws, size_t ws_size, hipStream_t stream) {
    static int grid = 0;
    if (grid == 0) {
        if (n_in != 23 || in_sizes[0] != T * DM || out_size != T * DM || ws_size < WS_END) { fprintf(stderr, "kernel_launch: unexpected shapes (n_in %d, x %d, out %d, ws %zu)\n", n_in, n_in > 0 ? in_sizes[0] : -1, out_size, ws_size); grid = -1; return; }
        if (hipFuncSetAttribute((const void*)mega, hipFuncAttributeMaxDynamicSharedMemorySize, LDS_BYTES) != hipSuccess) { fprintf(stderr, "kernel_launch: hipFuncSetAttribute failed\n"); grid = -1; return; }
        grid = 256;
    }
    if (grid < 0) return;
    Args a{};
    for (int i = 0; i < 23; ++i) a.in[i] = (const float*)d_in[i];
    a.out = (float*)d_out; a.ws = (unsigned char*)d_ws;
    if (hipMemsetAsync((char*)d_ws + WS_CTL, 0, 32 * 1024  , stream) != hipSuccess) { fprintf(stderr, "kernel_launch: memset failed\n"); return; }
    a.ph_lo = 0; a.ph_hi = NPHASE;
    hipLaunchKernelGGL(mega, dim3(grid), dim3(512), LDS_BYTES, stream, a);
}
```
